# Optimizing an MI355X kernel written in HIP

```python
import jax, jax.numpy as jnp
from jax import lax
import numpy as np

D_MODEL = 2048
BATCH = 2
SEQ = 8192
DEPTH = 1

D_MIX = D_MODEL
HG_HEADS = 8
HG_DK = 128
HG_DV = 128
HG_WIDTH = HG_HEADS * HG_DV
ML_HEADS = 4
ML_DQK = 128
ML_DV = 256
ML_WIDTH = ML_HEADS * ML_DV
CONV_W = 4
CHUNK = 64
N_EXPERTS = 32
TOP_K = 4
D_FF = 2048
SWIGLU_ALPHA = 1.702
SWIGLU_LIMIT = 7.0
MOE_BLOCK = 128
EPS = 1e-6

IN_SIZES = (
    HG_HEADS * HG_DK,
    HG_HEADS * HG_DK,
    HG_WIDTH,
    HG_WIDTH,
    ML_HEADS * ML_DQK,
    ML_HEADS * ML_DQK,
    ML_WIDTH,
    ML_WIDTH,
    ML_HEADS,
    ML_HEADS,
)
D_IN = sum(IN_SIZES)

kernel_name = "hymba_hgrn2_mlstm_moe"


def rms_norm(x, w):
    xf = x.astype(jnp.float32)
    y = xf * lax.rsqrt(jnp.mean(xf * xf, axis=-1, keepdims=True) + EPS)
    return (y * w.astype(jnp.float32)).astype(x.dtype)


def head_rms_norm(o, w):
    B, S, H, d = o.shape
    y = o * lax.rsqrt(jnp.mean(o * o, axis=-1, keepdims=True) + EPS)
    return y.reshape(B, S, H * d) * w.astype(jnp.float32)


def to_chunks(t, H):
    B, S, HD = t.shape
    return t.reshape(B, S // CHUNK, CHUNK, H, HD // H).transpose(1, 0, 3, 2, 4)


def gate_chunks(t):
    B, S, H = t.shape
    return t.reshape(B, S // CHUNK, CHUNK, H).transpose(1, 0, 3, 2)


def from_chunks(t):
    NC, B, H, C, d = t.shape
    return t.transpose(1, 0, 3, 2, 4).reshape(B, NC * C, H, d)


def causal_dwconv(u, w, b):
    out = lax.conv_general_dilated(
        u, w[:, None, :], window_strides=(1,), padding=[(CONV_W - 1, 0)],
        dimension_numbers=("NWC", "WIO", "NWC"), feature_group_count=u.shape[-1])
    return out + b


def hgrn2_mix(q, f_pre, i, g, lb, norm_w):
    f32 = jnp.float32
    B, S, _ = q.shape
    z = f_pre.astype(f32)
    lb = lb.astype(f32)
    log_f = jnp.logaddexp(jnp.log(lb), jnp.log1p(-lb) + jax.nn.log_sigmoid(z))
    k = (1.0 - lb) * jax.nn.sigmoid(-z)
    qc = to_chunks(q.astype(f32), HG_HEADS)
    kc = to_chunks(k, HG_HEADS)
    vc = to_chunks(i.astype(f32), HG_HEADS)
    fc = to_chunks(log_f, HG_HEADS)
    causal = jnp.tril(jnp.ones((CHUNK, CHUNK), dtype=bool))

    def step(state, inp):
        q_c, k_c, v_c, lf_c = inp
        b = jnp.cumsum(lf_c, axis=-2)
        inter = jnp.einsum("bhtk,bhkv->bhtv", q_c * jnp.exp(b), state)
        rel = b[:, :, :, None, :] - b[:, :, None, :, :]
        decay = jnp.exp(jnp.where(causal[:, :, None], rel, -jnp.inf))
        att = jnp.einsum("bhtk,bhsk,bhtsk->bhts", q_c, k_c, decay)
        intra = jnp.einsum("bhts,bhsv->bhtv", att, v_c)
        b_last = b[:, :, -1]
        k_dec = k_c * jnp.exp(b_last[:, :, None, :] - b)
        new_state = jnp.exp(b_last)[..., None] * state + jnp.einsum("bhsk,bhsv->bhkv", k_dec, v_c)
        return new_state, inter + intra

    s0 = jnp.zeros((B, HG_HEADS, HG_DK, HG_DV), f32)
    _, oc = lax.scan(step, s0, (qc, kc, vc, fc))
    o = from_chunks(oc)
    out = head_rms_norm(o, norm_w) * jax.nn.silu(g.astype(f32))
    return out.astype(q.dtype)


def mlstm_mix(q, k, v, o_pre, ig_pre, fg_pre, norm_w):
    f32 = jnp.float32
    B, S, _ = q.shape
    qc = to_chunks(q.astype(f32) * (ML_DQK ** -0.5), ML_HEADS)
    kc = to_chunks(k.astype(f32), ML_HEADS)
    vc = to_chunks(v.astype(f32), ML_HEADS)
    lic = gate_chunks(ig_pre.astype(f32))
    lfc = gate_chunks(jax.nn.log_sigmoid(fg_pre.astype(f32)))
    causal = jnp.tril(jnp.ones((CHUNK, CHUNK), dtype=bool))

    def step(carry, inp):
        Cm, n, m = carry
        q_c, k_c, v_c, li_c, lf_c = inp
        g = jnp.cumsum(lf_c, axis=-1)
        a_inter = g + m[..., None]
        dmat = g[..., :, None] - g[..., None, :] + li_c[..., None, :]
        dmat = jnp.where(causal, dmat, -jnp.inf)
        m_t = jnp.maximum(a_inter, jnp.max(dmat, axis=-1))
        w_inter = jnp.exp(a_inter - m_t)
        sqk = jnp.einsum("bhtd,bhsd->bhts", q_c, k_c) * jnp.exp(dmat - m_t[..., None])
        num = (w_inter[..., None] * jnp.einsum("bhtd,bhdv->bhtv", q_c, Cm)
               + jnp.einsum("bhts,bhsv->bhtv", sqk, v_c))
        den = w_inter * jnp.einsum("bhtd,bhd->bht", q_c, n) + jnp.sum(sqk, axis=-1)
        h = num / jnp.maximum(jnp.abs(den), jnp.exp(-m_t))[..., None]
        g_last = g[..., -1]
        log_ws = g_last[..., None] - g + li_c
        m_new = jnp.maximum(g_last + m, jnp.max(log_ws, axis=-1))
        decay = jnp.exp(g_last + m - m_new)
        ws = jnp.exp(log_ws - m_new[..., None])
        C_new = decay[..., None, None] * Cm + jnp.einsum("bhs,bhsd,bhsv->bhdv", ws, k_c, v_c)
        n_new = decay[..., None] * n + jnp.einsum("bhs,bhsd->bhd", ws, k_c)
        return (C_new, n_new, m_new), h

    init = (jnp.zeros((B, ML_HEADS, ML_DQK, ML_DV), f32),
            jnp.zeros((B, ML_HEADS, ML_DQK), f32),
            jnp.zeros((B, ML_HEADS), f32))
    _, hc = lax.scan(step, init, (qc, kc, vc, lic, lfc))
    h = from_chunks(hc)
    out = head_rms_norm(h, norm_w) * jax.nn.sigmoid(o_pre.astype(f32))
    return out.astype(q.dtype)


def moe_ffn(h, w_router, b_router, w_gate, b_gate, w_up, b_up, w_down, b_down):
    B, S, D = h.shape
    T = B * S
    A = T * TOP_K
    xf = h.reshape(T, D)
    logits = xf.astype(jnp.float32) @ w_router.astype(jnp.float32) + b_router.astype(jnp.float32)
    top_vals, top_idx = lax.top_k(logits, TOP_K)
    gates = jax.nn.softmax(top_vals, axis=-1)
    flat_e = top_idx.reshape(A).astype(jnp.int32)
    flat_tok = jnp.repeat(jnp.arange(T, dtype=jnp.int32), TOP_K)
    flat_gate = gates.reshape(A)
    order = jnp.argsort(flat_e)
    e_sorted = flat_e[order]
    tok_sorted = flat_tok[order]
    gate_sorted = flat_gate[order]
    counts = jnp.zeros((N_EXPERTS,), jnp.int32).at[flat_e].add(1)
    padded = ((counts + MOE_BLOCK - 1) // MOE_BLOCK) * MOE_BLOCK
    start = jnp.cumsum(counts) - counts
    pend = jnp.cumsum(padded)
    pstart = pend - padded
    dest = pstart[e_sorted] + (jnp.arange(A, dtype=jnp.int32) - start[e_sorted])
    n_blocks = (A + N_EXPERTS * (MOE_BLOCK - 1) + MOE_BLOCK - 1) // MOE_BLOCK
    n_slots = n_blocks * MOE_BLOCK
    slot_tok = jnp.zeros((n_slots,), jnp.int32).at[dest].set(tok_sorted)
    block_e = jnp.minimum(
        jnp.searchsorted(pend, jnp.arange(n_blocks, dtype=jnp.int32) * MOE_BLOCK, side="right"),
        N_EXPERTS - 1).astype(jnp.int32)
    xs = xf[slot_tok].reshape(n_blocks, MOE_BLOCK, D)

    def expert_block(args):
        xb, e = args
        gt = xb @ w_gate[e] + b_gate[e]
        up = xb @ w_up[e] + b_up[e]
        gt = jnp.minimum(gt, SWIGLU_LIMIT)
        up = jnp.clip(up, -SWIGLU_LIMIT, SWIGLU_LIMIT)
        act = (up + 1.0) * (gt * jax.nn.sigmoid(SWIGLU_ALPHA * gt))
        return act @ w_down[e] + b_down[e]

    ys = lax.map(expert_block, (xs, block_e)).reshape(n_slots, D)
    contrib = ys[dest] * gate_sorted[:, None].astype(ys.dtype)
    out = jax.ops.segment_sum(contrib, tok_sorted, num_segments=T)
    return out.reshape(B, S, D).astype(h.dtype)


def setup_inputs(seed: int = 0) -> dict:
    key = jax.random.key(seed)
    ks = jax.random.split(key, 24)
    f32 = jnp.float32
    nrm = lambda k, shp, s: jax.random.normal(k, shp, f32) * s
    return {
        "x": jax.random.normal(ks[0], (BATCH, SEQ, D_MODEL), f32),
        "ln1_w": 1.0 + nrm(ks[1], (DEPTH, D_MODEL), 0.02),
        "w_in": nrm(ks[2], (DEPTH, D_MODEL, D_IN), D_MODEL ** -0.5),
        "hg_lb_logits": nrm(ks[3], (DEPTH + 1, HG_HEADS * HG_DK), 0.1),
        "hg_norm_w": 1.0 + nrm(ks[4], (DEPTH, HG_WIDTH), 0.02),
        "ml_conv_w": nrm(ks[5], (DEPTH, CONV_W, 2 * ML_HEADS * ML_DQK), CONV_W ** -0.5),
        "ml_conv_b": nrm(ks[6], (DEPTH, 2 * ML_HEADS * ML_DQK), 0.02),
        "ml_igate_b": nrm(ks[7], (DEPTH, ML_HEADS), 0.1),
        "ml_fgate_b": jax.random.uniform(ks[8], (DEPTH, ML_HEADS), f32, 3.0, 6.0),
        "ml_norm_w": 1.0 + nrm(ks[9], (DEPTH, ML_WIDTH), 0.02),
        "w_out": nrm(ks[10], (DEPTH, D_MIX, D_MODEL), D_MIX ** -0.5),
        "ln2_w": 1.0 + nrm(ks[11], (DEPTH, D_MODEL), 0.02),
        "w_router": nrm(ks[12], (DEPTH, D_MODEL, N_EXPERTS), D_MODEL ** -0.5),
        "b_router": nrm(ks[13], (DEPTH, N_EXPERTS), 0.01),
        "w_gate": nrm(ks[14], (DEPTH, N_EXPERTS, D_MODEL, D_FF), D_MODEL ** -0.5),
        "b_gate": nrm(ks[15], (DEPTH, N_EXPERTS, D_FF), 0.02),
        "w_up": nrm(ks[16], (DEPTH, N_EXPERTS, D_MODEL, D_FF), D_MODEL ** -0.5),
        "b_up": nrm(ks[17], (DEPTH, N_EXPERTS, D_FF), 0.02),
        "w_down": nrm(ks[18], (DEPTH, N_EXPERTS, D_FF, D_MODEL), D_FF ** -0.5),
        "b_down": nrm(ks[19], (DEPTH, N_EXPERTS, D_MODEL), 0.02),
        "final_norm_w": 1.0 + nrm(ks[20], (D_MODEL,), 0.02),
    }


def reference(x, ln1_w, w_in, hg_lb_logits, hg_norm_w, ml_conv_w, ml_conv_b, ml_igate_b,
              ml_fgate_b, ml_norm_w, w_out, ln2_w, w_router, b_router, w_gate, b_gate,
              w_up, b_up, w_down, b_down, final_norm_w):
    lb_all = jnp.cumsum(jax.nn.softmax(hg_lb_logits.astype(jnp.float32), axis=0), axis=0)
    split_idx = [int(v) for v in np.cumsum(IN_SIZES)[:-1]]
    qk_w = ML_HEADS * ML_DQK
    for l in range(DEPTH):
        h = rms_norm(x, ln1_w[l])
        proj = h @ w_in[l]
        hq, hf, hi, hg, mq, mk, mv, mo, mig, mfg = jnp.split(proj, split_idx, axis=-1)
        qk = jax.nn.silu(causal_dwconv(jnp.concatenate([mq, mk], axis=-1), ml_conv_w[l], ml_conv_b[l]))
        mq, mk = qk[..., :qk_w], qk[..., qk_w:]
        a_out = hgrn2_mix(hq, hf, hi, hg, lb_all[l], hg_norm_w[l])
        b_out = mlstm_mix(mq, mk, mv, mo, mig + ml_igate_b[l], mfg + ml_fgate_b[l],
                          ml_norm_w[l])
        x = x + jnp.concatenate([a_out, b_out], axis=-1) @ w_out[l]
        x = x + moe_ffn(rms_norm(x, ln2_w[l]), w_router[l], b_router[l], w_gate[l], b_gate[l],
                        w_up[l], b_up[l], w_down[l], b_down[l])
    return rms_norm(x, final_norm_w)
```

```cpp
#include <hip/hip_runtime.h>
#include <cstdio>
#include <cstdint>

#ifndef MK_N_LAUNCHES
#define MK_N_LAUNCHES 1
#endif

constexpr int T_TOK = 16384, SEQ = 8192, DM = 2048, D_IN = 7176, NPROJ = 7168;
constexpr int NCHUNK = 128;
constexpr int NEXP = 32, TOPK = 4, DFF = 2048;
constexpr int LIST_STRIDE = 16384;
constexpr int MAX_TILES = 288;
constexpr float EPS = 1e-6f;
constexpr int C_HQ = 0, C_HF = 1024, C_HI = 2048, C_HG = 3072, C_MQ = 4096, C_MK = 4608, C_MV = 5120, C_MO = 6144;

#define GAS __attribute__((address_space(1)))
#define LAS __attribute__((address_space(3)))
typedef unsigned short bf16_t;
typedef short bf16x8 __attribute__((ext_vector_type(8)));
typedef float f32x4 __attribute__((ext_vector_type(4)));
typedef float f32x16 __attribute__((ext_vector_type(16)));
typedef unsigned u32x4 __attribute__((ext_vector_type(4)));
typedef unsigned u32x2 __attribute__((ext_vector_type(2)));
typedef int i32x4 __attribute__((ext_vector_type(4)));
typedef int i32x8 __attribute__((ext_vector_type(8)));

typedef float f32x2_t __attribute__((ext_vector_type(2)));
typedef __bf16 bf16x2_t __attribute__((ext_vector_type(2)));
__device__ __forceinline__ unsigned cvt_pk_bf16(float lo, float hi) { const f32x2_t v = {lo, hi}; return __builtin_bit_cast(unsigned, __builtin_convertvector(v, bf16x2_t)); }
__device__ __forceinline__ unsigned cvt4_fp8(float a, float b, float c, float d) { int w = 0; w = __builtin_amdgcn_cvt_pk_fp8_f32(a, b, w, false); w = __builtin_amdgcn_cvt_pk_fp8_f32(c, d, w, true); return (unsigned)w; }
__device__ __forceinline__ float bf2f(bf16_t b) { return __uint_as_float(((unsigned)b) << 16); }
__device__ __forceinline__ float bflo(unsigned w) { return __uint_as_float(w << 16); }
__device__ __forceinline__ float bfhi(unsigned w) { return __uint_as_float(w & 0xffff0000u); }
__device__ __forceinline__ float sigmoidf_(float x) { return __builtin_amdgcn_rcpf(1.0f + __expf(-x)); }
__device__ __forceinline__ float sig1702_(float x) { return __builtin_amdgcn_rcpf(1.0f + __builtin_amdgcn_exp2f(x * -2.4554669f)); }

namespace pg8 {
constexpr int BM = 256, BK = 64, HALF = 128, HTB = HALF * BK * 2, STAGE_BYTES = 8 * HTB, NXCD = 8, WGM = 8;
__host__ __device__ __forceinline__ int lds_byte(int r, int c) { const int st = (r >> 4) * 2 + (c >> 5), rr = r & 15, cc = c & 31, ob = rr * 64 + cc * 2; return st * 1024 + (ob ^ (((ob >> 9) & 1) << 5)); }
__host__ __device__ __forceinline__ void stage_rc(int b, int& R, int& C) { const int st = b / 1024, sb = b % 1024, swz = sb ^ (((sb >> 9) & 1) << 5); R = (st >> 1) * 16 + swz / 64; C = (st & 1) * 32 + (swz % 64) / 2; }
__host__ __device__ __forceinline__ int perm32(int rho) { const int n = rho >> 4, i = rho & 15; return 8 * (i >> 2) + 4 * n + (i & 3); }

struct Unit { int pm, pn, e, r0; };
struct Gemm { const bf16_t* A; const bf16_t* Bt; int K; };

struct StaticOrder {
    int nM, nN, nwg, G, c;
    __device__ void init(int M, int N, int G_, int c_) { nM = M / BM; nN = N / BM; nwg = nM * nN; G = G_; c = c_; }
    __device__ bool next(int i, Unit& u) const {
        const long L = (long)i * G + c; if (L >= nwg) return false;
        int wgid = (int)L; { const int q = nwg / NXCD, r = nwg % NXCD, xcd = wgid % NXCD, off = wgid / NXCD; wgid = (xcd < r ? xcd * (q + 1) : r * (q + 1) + (xcd - r) * q) + off; }
        const int nig = WGM * nN, gid = wgid / nig, fm = gid * WGM, gsz = (nM - fm) < WGM ? (nM - fm) : WGM;
        u.pm = fm + ((wgid % nig) % gsz); u.pn = (wgid % nig) / gsz; u.e = 0; u.r0 = 0; return true;
    }
    __device__ __forceinline__ unsigned tok(const Unit&, int) const { return 0u; }
};
struct MoeOrder {
    const LAS int* tile0;
    const LAS int* cnt;
    const int* list_tok;
    int NC, nwg, G, c;
    __device__ void init(const LAS int* t0, const LAS int* cn, const int* lt, int NC_, int G_, int c_) { tile0 = t0; cnt = cn; list_tok = lt; NC = NC_; nwg = t0[NEXP] * NC_; G = G_; c = c_; }
    __device__ bool next(int i, Unit& u) const {
        const long L = (long)i * G + c; if (L >= nwg) return false;
        int wgid = (int)L; { const int q = nwg / NXCD, r = nwg % NXCD, xcd = wgid % NXCD, off = wgid / NXCD; wgid = (xcd < r ? xcd * (q + 1) : r * (q + 1) + (xcd - r) * q) + off; }
        int e = 0;
        for (int j = 1; j < NEXP; ++j) if (tile0[j] * NC <= wgid) e = j;
        const int nr = tile0[e + 1] - tile0[e], idx = wgid - tile0[e] * NC;
        const int r = idx % nr, cn = idx / nr;
        u.e = __builtin_amdgcn_readfirstlane(e); u.pm = __builtin_amdgcn_readfirstlane(tile0[e] + r); u.pn = __builtin_amdgcn_readfirstlane(e * NC + cn); u.r0 = __builtin_amdgcn_readfirstlane(r * BM); return true;
    }
    __device__ __forceinline__ unsigned tok(const Unit& u, int row) const { const int p = u.r0 + row; const bool ok = p < cnt[u.e]; const unsigned t = (unsigned)list_tok[u.e * LIST_STRIDE + (ok ? p : 0)]; return ok ? t : 0u; }
};

template <class Epi, class Sched, bool GATHER, bool ALIGN_EPI, bool SP2, bool FP8>
__device__ __forceinline__ void gemm_phase(LAS unsigned char* lds, const Gemm g, const Sched& S, const Epi& E) {
    const int tid = threadIdx.x, wid = __builtin_amdgcn_readfirstlane(tid >> 6), lane = tid & 63, wr = wid >> 2, wc = wid & 3, fr = lane & 15, fq = lane >> 4;
    const int K = g.K, nt = K / BK;
    u32x2 vA0, vA1; unsigned voffB[2];
    int Rr[2], Cc[2];
#pragma unroll
    for (int i = 0; i < 2; ++i) { int R, C; stage_rc(tid * 16 + i * 8192, R, C); Rr[i] = R; Cc[i] = C; const int Rb = (R & ~31) + perm32(R & 31); voffB[i] = (unsigned)(Rb * K + C) * 2u; }
    const int kstep = BK * 2;
    const int hstep = HALF * K * 2;
    const int tstep = 2 * hstep;
    const unsigned ldsw = (unsigned)wid * 1024u;
    const int aoff = lds_byte(wr * 64 + fr, fq * 8), boff = lds_byte(wc * 32 + fr, fq * 8);
    const __amdgpu_buffer_rsrc_t rsA = __builtin_amdgcn_make_buffer_rsrc((void*)g.A, 0, 0xFFFFFFF0u, 0x00020000);
    const __amdgpu_buffer_rsrc_t rsB = __builtin_amdgcn_make_buffer_rsrc((void*)g.Bt, 0, 0xFFFFFFF0u, 0x00020000);
#define PG8_OFFA(u, _row, _i) (GATHER ? (S.tok(u, _row) * (unsigned)(K * 2) + (unsigned)(Cc[_i] * 2)) : (unsigned)((_row) * K + Cc[_i]) * 2u)
#define PG8_SETA(d0, d1, u) do { d0.x = PG8_OFFA(u, Rr[0], 0); d0.y = PG8_OFFA(u, Rr[1], 1); d1.x = PG8_OFFA(u, HALF + Rr[0], 0); d1.y = PG8_OFFA(u, HALF + Rr[1], 1); } while (0)
#define PG8_SA(b, h) (((b) * 2 + (h)) * HTB)
#define PG8_SB(b, h) ((4 + (b) * 2 + (h)) * HTB)
#define PG8_STAGE_A(bufoff, soff, voff) do { _Pragma("unroll") for (int _i = 0; _i < 2; ++_i) \
        __builtin_amdgcn_raw_ptr_buffer_load_lds(rsA, (LAS void*)(lds + (bufoff) + ldsw + _i * 8192), 16, (voff)[_i], (soff), 0, 0); } while (0)
#define PG8_STAGE_B(bufoff, soff) do { _Pragma("unroll") for (int _i = 0; _i < 2; ++_i) \
        __builtin_amdgcn_raw_ptr_buffer_load_lds(rsB, (LAS void*)(lds + (bufoff) + ldsw + _i * 8192), 16, voffB[_i], (soff), 0, 0); } while (0)
#define PG8_LD8(base_) __builtin_shufflevector(*(const LAS i32x4*)(base_), *(const LAS i32x4*)((base_) + 1024), 0, 1, 2, 3, 4, 5, 6, 7)
#define PG8_LDA(dst, b, h) do { _Pragma("unroll") for (int m = 0; m < 4; ++m) dst[m] = PG8_LD8(lds + PG8_SA(b, h) + aoff + m * 2048); } while (0)
#define PG8_LDB(dst, b, h) do { _Pragma("unroll") for (int n = 0; n < 2; ++n) dst[n] = PG8_LD8(lds + PG8_SB(b, h) + boff + n * 2048); } while (0)
#define PG8_LO(v) __builtin_bit_cast(bf16x8, __builtin_shufflevector(v, v, 0, 1, 2, 3))
#define PG8_HI(v) __builtin_bit_cast(bf16x8, __builtin_shufflevector(v, v, 4, 5, 6, 7))
#define PG8_MMA(ai, bj, At, Bt) do { __builtin_amdgcn_s_setprio(1); _Pragma("unroll") for (int m = 0; m < 4; ++m) _Pragma("unroll") for (int n = 0; n < 2; ++n) { \
        if constexpr (FP8) asm volatile("v_mfma_f32_16x16x128_f8f6f4 %0, %1, %2, %0" : "+v"(acc[ai][bj][m][n]) : "v"(Bt[n]), "v"(At[m])); \
        else { asm volatile("v_mfma_f32_16x16x32_bf16 %0, %1, %2, %0" : "+v"(acc[ai][bj][m][n]) : "v"(PG8_LO(Bt[n])), "v"(PG8_LO(At[m]))); \
               asm volatile("v_mfma_f32_16x16x32_bf16 %0, %1, %2, %0" : "+v"(acc[ai][bj][m][n]) : "v"(PG8_HI(Bt[n])), "v"(PG8_HI(At[m]))); } } \
        __builtin_amdgcn_s_setprio(0); } while (0)
#define PG8_WAIT_V(n) asm volatile("s_waitcnt vmcnt(" #n ")" ::: "memory")
#define PG8_WAIT_L(n) asm volatile("s_waitcnt lgkmcnt(" #n ")" ::: "memory")
#define PG8_BAR __builtin_amdgcn_s_barrier()
#define PG8_SCHED __builtin_amdgcn_sched_barrier(0)
    Unit cur, nxt; int ui = 0;
    if (!S.next(0, cur)) return;
    typename Epi::Pre pre{};
    f32x4 acc[2][2][4][2];
#pragma unroll
    for (int a = 0; a < 2; ++a)
#pragma unroll
        for (int b = 0; b < 2; ++b)
#pragma unroll
            for (int m = 0; m < 4; ++m)
#pragma unroll
                for (int n = 0; n < 2; ++n) acc[a][b][m][n] = (f32x4){0.f, 0.f, 0.f, 0.f};
    i32x8 At[4], B0[2], B1[2];
    int cA = GATHER ? 0 : cur.pm * tstep, cB = cur.pn * tstep;
    PG8_SETA(vA0, vA1, cur);
    if constexpr (SP2) {
        PG8_STAGE_B(PG8_SB(0, 0), cB); PG8_STAGE_B(PG8_SB(0, 1), cB + hstep); PG8_STAGE_A(PG8_SA(0, 0), cA, vA0); PG8_STAGE_A(PG8_SA(0, 1), cA, vA1);
        if (wr == 1) PG8_BAR;
        PG8_WAIT_V(2); PG8_BAR;
        PG8_STAGE_B(PG8_SB(1, 0), cB + kstep); PG8_STAGE_A(PG8_SA(1, 0), cA + kstep, vA0); PG8_STAGE_B(PG8_SB(1, 1), cB + hstep + kstep);
        PG8_WAIT_V(6); PG8_BAR;
    } else {
        PG8_STAGE_B(PG8_SB(0, 0), cB); PG8_STAGE_A(PG8_SA(0, 0), cA, vA0); PG8_STAGE_B(PG8_SB(0, 1), cB + hstep); PG8_STAGE_A(PG8_SA(0, 1), cA, vA1);
        if (wr == 1) PG8_BAR;
        PG8_WAIT_V(4); PG8_BAR;
        PG8_STAGE_B(PG8_SB(1, 0), cB + kstep); PG8_STAGE_A(PG8_SA(1, 0), cA + kstep, vA0); PG8_STAGE_B(PG8_SB(1, 1), cB + hstep + kstep);
        PG8_WAIT_V(6); PG8_BAR;
    }
    for (;;) {
        const bool has_next = S.next(ui + 1, nxt);
        const int nA = has_next ? (GATHER ? 0 : nxt.pm * tstep) : cA, nB = has_next ? nxt.pn * tstep : cB;
        u32x2 nvA0 = vA0, nvA1 = vA1;
        if constexpr (GATHER) { if (has_next) PG8_SETA(nvA0, nvA1, nxt); }
        for (int t = 0; t < nt; t += 2) {
            const bool last = (t == nt - 2);
            if (last) pre = E.prefetch(cur, wr, wc, fr, fq);
            const int a1 = cA + (t + 1) * kstep;
            const int a2 = last ? nA : cA + (t + 2) * kstep, b2 = last ? nB : cB + (t + 2) * kstep;
            const int a3 = a2 + kstep, b3 = b2 + kstep;
            const u32x2 va20 = (GATHER && last) ? nvA0 : vA0, va21 = (GATHER && last) ? nvA1 : vA1;
            if constexpr (SP2) {
            PG8_LDB(B0, 0, 0); PG8_LDB(B1, 0, 1); PG8_SCHED; PG8_LDA(At, 0, 0); PG8_STAGE_A(PG8_SA(1, 1), a1, vA1);
            PG8_WAIT_V(8); PG8_WAIT_L(0); PG8_BAR; PG8_MMA(0, 0, At, B0); PG8_MMA(0, 1, At, B1); PG8_BAR; PG8_SCHED;
            PG8_LDA(At, 0, 1); PG8_STAGE_B(PG8_SB(0, 0), b2); PG8_STAGE_B(PG8_SB(0, 1), b2 + hstep); PG8_STAGE_A(PG8_SA(0, 0), a2, va20);
            PG8_WAIT_V(8); PG8_WAIT_L(0); PG8_BAR; PG8_MMA(1, 0, At, B0); PG8_MMA(1, 1, At, B1); PG8_BAR; PG8_SCHED;
            PG8_LDB(B0, 1, 0); PG8_LDB(B1, 1, 1); PG8_SCHED; PG8_LDA(At, 1, 0); PG8_STAGE_A(PG8_SA(0, 1), a2, va21);
            PG8_WAIT_V(8); PG8_WAIT_L(0); PG8_BAR; PG8_MMA(0, 0, At, B0); PG8_MMA(0, 1, At, B1); PG8_BAR; PG8_SCHED;
            PG8_LDA(At, 1, 1); PG8_STAGE_B(PG8_SB(1, 0), b3); PG8_STAGE_B(PG8_SB(1, 1), b3 + hstep); PG8_STAGE_A(PG8_SA(1, 0), a3, va20);
            PG8_WAIT_V(8); PG8_WAIT_L(0); PG8_BAR; PG8_MMA(1, 0, At, B0); PG8_MMA(1, 1, At, B1); PG8_BAR; PG8_SCHED;
            } else {
            PG8_LDB(B0, 0, 0); PG8_SCHED; PG8_LDA(At, 0, 0); PG8_STAGE_A(PG8_SA(1, 1), a1, vA1);
            PG8_WAIT_L(8); PG8_BAR; PG8_WAIT_L(0); PG8_MMA(0, 0, At, B0); PG8_BAR; PG8_SCHED;
            PG8_LDB(B1, 0, 1); PG8_STAGE_B(PG8_SB(0, 0), b2);
            PG8_BAR; PG8_WAIT_L(0); PG8_MMA(0, 1, At, B1); PG8_BAR;
            PG8_LDA(At, 0, 1); PG8_STAGE_A(PG8_SA(0, 0), a2, va20);
            PG8_BAR; PG8_WAIT_L(0); PG8_MMA(1, 0, At, B0); PG8_BAR; PG8_SCHED;
            PG8_STAGE_B(PG8_SB(0, 1), b2 + hstep);
            PG8_WAIT_V(6); PG8_BAR; PG8_MMA(1, 1, At, B1); PG8_BAR;
            PG8_LDB(B0, 1, 0); PG8_SCHED; PG8_LDA(At, 1, 0); PG8_STAGE_A(PG8_SA(0, 1), a2, va21);
            PG8_WAIT_L(8); PG8_BAR; PG8_WAIT_L(0); PG8_MMA(0, 0, At, B0); PG8_BAR; PG8_SCHED;
            PG8_LDB(B1, 1, 1); PG8_STAGE_B(PG8_SB(1, 0), b3);
            PG8_BAR; PG8_WAIT_L(0); PG8_MMA(0, 1, At, B1); PG8_BAR;
            PG8_LDA(At, 1, 1); PG8_STAGE_A(PG8_SA(1, 0), a3, va20);
            PG8_BAR; PG8_WAIT_L(0); PG8_MMA(1, 0, At, B0); PG8_BAR; PG8_SCHED;
            PG8_STAGE_B(PG8_SB(1, 1), b3 + hstep);
            PG8_WAIT_V(6); PG8_BAR; PG8_MMA(1, 1, At, B1); PG8_BAR;
            }
        }
        if constexpr (ALIGN_EPI) { if (wr == 0) PG8_BAR; }
        {
            asm volatile("s_nop 15\n\ts_nop 3" : "+v"(acc[0][0][0][0]), "+v"(acc[0][0][0][1]), "+v"(acc[0][0][1][0]), "+v"(acc[0][0][1][1]), "+v"(acc[0][0][2][0]), "+v"(acc[0][0][2][1]), "+v"(acc[0][0][3][0]), "+v"(acc[0][0][3][1]));
            asm volatile("" : "+v"(acc[0][1][0][0]), "+v"(acc[0][1][0][1]), "+v"(acc[0][1][1][0]), "+v"(acc[0][1][1][1]), "+v"(acc[0][1][2][0]), "+v"(acc[0][1][2][1]), "+v"(acc[0][1][3][0]), "+v"(acc[0][1][3][1]));
            asm volatile("" : "+v"(acc[1][0][0][0]), "+v"(acc[1][0][0][1]), "+v"(acc[1][0][1][0]), "+v"(acc[1][0][1][1]), "+v"(acc[1][0][2][0]), "+v"(acc[1][0][2][1]), "+v"(acc[1][0][3][0]), "+v"(acc[1][0][3][1]));
            asm volatile("" : "+v"(acc[1][1][0][0]), "+v"(acc[1][1][0][1]), "+v"(acc[1][1][1][0]), "+v"(acc[1][1][1][1]), "+v"(acc[1][1][2][0]), "+v"(acc[1][1][2][1]), "+v"(acc[1][1][3][0]), "+v"(acc[1][1][3][1]));
        }
        { Unit eu = cur; asm volatile("" : "+s"(eu.pm), "+s"(eu.pn), "+s"(eu.e), "+s"(eu.r0));
          int tid2 = threadIdx.x; asm volatile("" : "+v"(tid2));
          const int wid2 = __builtin_amdgcn_readfirstlane(tid2 >> 6), lane2 = tid2 & 63;
          E(acc, eu, pre, wid2 >> 2, wid2 & 3, lane2 & 15, lane2 >> 4); }
        if (!has_next) break;
#pragma unroll
        for (int a = 0; a < 2; ++a)
#pragma unroll
            for (int b = 0; b < 2; ++b)
#pragma unroll
                for (int m = 0; m < 4; ++m)
#pragma unroll
                    for (int n = 0; n < 2; ++n) acc[a][b][m][n] = (f32x4){0.f, 0.f, 0.f, 0.f};
        cur = nxt; cA = nA; cB = nB; ++ui;
        vA0 = nvA0; vA1 = nvA1;
        if constexpr (ALIGN_EPI) { if (wr == 1) PG8_BAR; }
    }
    PG8_WAIT_V(0);
    if constexpr (!ALIGN_EPI) { if (wr == 0) PG8_BAR; }
    PG8_BAR;
#undef PG8_SETA
#undef PG8_OFFA
#undef PG8_SA
#undef PG8_SB
#undef PG8_STAGE_A
#undef PG8_STAGE_B
#undef PG8_LDA
#undef PG8_LD8
#undef PG8_LO
#undef PG8_HI
#undef PG8_LDB
#undef PG8_MMA
#undef PG8_WAIT_V
#undef PG8_WAIT_L
#undef PG8_BAR
#undef PG8_SCHED
}
}

struct EpiProj {
    bf16_t* O; const float* rstd;
    static constexpr int NSTORE = 16;
    struct Pre { f32x4 ra, rb; };
    __device__ __forceinline__ Pre prefetch(const pg8::Unit& u, int wr, int, int fr, int) const { Pre q; const int row0 = u.pm * 256 + wr * 64 + fr;
#pragma unroll
        for (int i = 0; i < 4; ++i) { q.ra[i] = rstd[row0 + i * 16]; q.rb[i] = rstd[row0 + 128 + i * 16]; }
        return q; }
    __device__ __forceinline__ void operator()(const f32x4 (&acc)[2][2][4][2], const pg8::Unit& u, const Pre& pre, int wr, int wc, int fr, int fq) const {
        const int row0 = u.pm * 256 + wr * 64 + fr, col0 = u.pn * 256 + wc * 32 + 8 * fq;
        float rsv[8];
#pragma unroll
        for (int i = 0; i < 4; ++i) { rsv[i] = pre.ra[i]; rsv[4 + i] = pre.rb[i]; }
#pragma unroll
        for (int ai = 0; ai < 2; ++ai)
#pragma unroll
            for (int m = 0; m < 4; ++m) { const int row = row0 + ai * 128 + m * 16; const float rs = rsv[ai * 4 + m]; bf16_t* rowp = O + (size_t)row * NPROJ + col0;
#pragma unroll
                for (int bj = 0; bj < 2; ++bj) { const f32x4 v0 = acc[ai][bj][m][0] * rs, v1 = acc[ai][bj][m][1] * rs;
                    u32x4 w; w.x = cvt_pk_bf16(v0[0], v0[1]); w.y = cvt_pk_bf16(v0[2], v0[3]); w.z = cvt_pk_bf16(v1[0], v1[1]); w.w = cvt_pk_bf16(v1[2], v1[3]);
                    *(u32x4*)(rowp + bj * 128) = w; } }
    }
};
struct EpiOut {
    const float* X; float* X1; unsigned char* X1b;
    static constexpr int NSTORE = 48;
    struct Pre { int none; };
    __device__ __forceinline__ Pre prefetch(const pg8::Unit&, int, int, int, int) const { return Pre{0}; }
    __device__ __forceinline__ void operator()(const f32x4 (&acc)[2][2][4][2], const pg8::Unit& u, const Pre&, int wr, int wc, int fr, int fq) const {
        const int row0 = u.pm * 256 + wr * 64 + fr, col0 = u.pn * 256 + wc * 32 + 8 * fq;
        f32x4 xa[2][2], xb[2][2];
#define EPO_LOAD(dst, g) do { const size_t off_ = (size_t)(row0 + ((g) >> 2) * 128 + ((g) & 3) * 16) * DM + col0; \
        _Pragma("unroll") for (int bj_ = 0; bj_ < 2; ++bj_) { dst[bj_][0] = *(const f32x4*)(X + off_ + bj_ * 128); dst[bj_][1] = *(const f32x4*)(X + off_ + bj_ * 128 + 4); } } while (0)
#define EPO_DO(src, g) do { const int ai_ = (g) >> 2, m_ = (g) & 3; const size_t off_ = (size_t)(row0 + ai_ * 128 + m_ * 16) * DM + col0; \
        _Pragma("unroll") for (int bj_ = 0; bj_ < 2; ++bj_) { const f32x4 v0 = acc[ai_][bj_][m_][0] + src[bj_][0], v1 = acc[ai_][bj_][m_][1] + src[bj_][1]; \
            *(f32x4*)(X1 + off_ + bj_ * 128) = v0; *(f32x4*)(X1 + off_ + bj_ * 128 + 4) = v1; \
            u32x2 w_; w_.x = cvt4_fp8(v0[0], v0[1], v0[2], v0[3]); w_.y = cvt4_fp8(v1[0], v1[1], v1[2], v1[3]); *(u32x2*)(X1b + off_ + bj_ * 128) = w_; } } while (0)
        EPO_LOAD(xa, 0);
        EPO_LOAD(xb, 1); __builtin_amdgcn_sched_barrier(0); EPO_DO(xa, 0); __builtin_amdgcn_sched_barrier(0);
        EPO_LOAD(xa, 2); __builtin_amdgcn_sched_barrier(0); EPO_DO(xb, 1); __builtin_amdgcn_sched_barrier(0);
        EPO_LOAD(xb, 3); __builtin_amdgcn_sched_barrier(0); EPO_DO(xa, 2); __builtin_amdgcn_sched_barrier(0);
        EPO_LOAD(xa, 4); __builtin_amdgcn_sched_barrier(0); EPO_DO(xb, 3); __builtin_amdgcn_sched_barrier(0);
        EPO_LOAD(xb, 5); __builtin_amdgcn_sched_barrier(0); EPO_DO(xa, 4); __builtin_amdgcn_sched_barrier(0);
        EPO_LOAD(xa, 6); __builtin_amdgcn_sched_barrier(0); EPO_DO(xb, 5); __builtin_amdgcn_sched_barrier(0);
        EPO_LOAD(xb, 7); __builtin_amdgcn_sched_barrier(0); EPO_DO(xa, 6); __builtin_amdgcn_sched_barrier(0);
        EPO_DO(xb, 7);
#undef EPO_LOAD
#undef EPO_DO
    }
};
struct EpiMoe1 {
    unsigned char* ACT; const float* bg; const float* bu; const float* list_rs; const LAS int* cnt;
    static constexpr int NSTORE = 8;
    struct Pre { f32x4 g0, g1, u0, u1; };
    __device__ __forceinline__ Pre prefetch(const pg8::Unit& u, int wr, int wc, int fr, int fq) const { Pre q; const int e = u.e, cn = u.pn - e * 16, col = cn * 128 + wc * 32 + 8 * fq, ce = cnt[e];
        q.g0 = *(const f32x4*)(bg + e * DFF + col); q.g1 = *(const f32x4*)(bg + e * DFF + col + 4); q.u0 = *(const f32x4*)(bu + e * DFF + col); q.u1 = *(const f32x4*)(bu + e * DFF + col + 4);
        (void)ce; (void)wr; (void)fr; return q; }
    __device__ __forceinline__ void operator()(const f32x4 (&acc)[2][2][4][2], const pg8::Unit& u, const Pre& pre, int wr, int wc, int fr, int fq) const {
        const int e = u.e, cn = u.pn - e * 16, col = cn * 128 + wc * 32 + 8 * fq, ce = cnt[e];
        const f32x4 g0 = pre.g0, g1 = pre.g1, u0 = pre.u0, u1 = pre.u1;
        float rsv[8];
#pragma unroll
        for (int i = 0; i < 8; ++i) { const int p = u.r0 + (i >> 2) * 128 + wr * 64 + (i & 3) * 16 + fr; rsv[i] = list_rs[e * LIST_STRIDE + (p < ce ? p : 0)]; }
#pragma unroll
        for (int ai = 0; ai < 2; ++ai)
#pragma unroll
            for (int m = 0; m < 4; ++m) { const int rit = ai * 128 + wr * 64 + m * 16 + fr, p = u.r0 + rit; const float rs = (p < ce) ? rsv[ai * 4 + m] * 0.015625f : 0.f;
                f32x4 gt0 = acc[ai][0][m][0] * rs + g0, gt1 = acc[ai][0][m][1] * rs + g1, up0 = acc[ai][1][m][0] * rs + u0, up1 = acc[ai][1][m][1] * rs + u1;
                float o[8];
#pragma unroll
                for (int j = 0; j < 4; ++j) { float gv = fminf(gt0[j], 7.0f), uv = fminf(fmaxf(up0[j], -7.0f), 7.0f); o[j] = (uv + 1.0f) * (gv * sig1702_(gv));
                    gv = fminf(gt1[j], 7.0f); uv = fminf(fmaxf(up1[j], -7.0f), 7.0f); o[4 + j] = (uv + 1.0f) * (gv * sig1702_(gv)); }
                u32x2 w; w.x = cvt4_fp8(o[0], o[1], o[2], o[3]); w.y = cvt4_fp8(o[4], o[5], o[6], o[7]);
                *(u32x2*)(ACT + (size_t)(u.pm * 256 + rit) * DFF + col) = w; }
    }
};
struct EpiMoe2 {
    unsigned char* YS; const float* bd;
    static constexpr int NSTORE = 16;
    struct Pre { f32x4 bv[2][2]; };
    __device__ __forceinline__ Pre prefetch(const pg8::Unit& u, int wr, int wc, int fr, int fq) const { Pre q; const int e = u.e, cn = u.pn - e * 8, col0 = cn * 256 + wc * 32 + 8 * fq;
#pragma unroll
        for (int bj = 0; bj < 2; ++bj) { q.bv[bj][0] = *(const f32x4*)(bd + e * DM + col0 + bj * 128); q.bv[bj][1] = *(const f32x4*)(bd + e * DM + col0 + bj * 128 + 4); }
        return q; }
    __device__ __forceinline__ void operator()(const f32x4 (&acc)[2][2][4][2], const pg8::Unit& u, const Pre& pre, int wr, int wc, int fr, int fq) const {
        const int e = u.e, cn = u.pn - e * 8, col0 = cn * 256 + wc * 32 + 8 * fq;
        f32x4 bv[2][2];
#pragma unroll
        for (int bj = 0; bj < 2; ++bj) { bv[bj][0] = pre.bv[bj][0]; bv[bj][1] = pre.bv[bj][1]; }
#pragma unroll
        for (int ai = 0; ai < 2; ++ai)
#pragma unroll
            for (int m = 0; m < 4; ++m) { unsigned char* rowp = YS + (size_t)(u.pm * 256 + ai * 128 + wr * 64 + m * 16 + fr) * DM + col0;
#pragma unroll
                for (int bj = 0; bj < 2; ++bj) { const f32x4 v0 = acc[ai][bj][m][0] * 0.015625f + bv[bj][0], v1 = acc[ai][bj][m][1] * 0.015625f + bv[bj][1];
                    u32x2 w; w.x = cvt4_fp8(v0[0], v0[1], v0[2], v0[3]); w.y = cvt4_fp8(v1[0], v1[1], v1[2], v1[3]);
                    *(u32x2*)(rowp + bj * 128) = w; } }
    }
};

#define XB_TMO      128
#define XB_XCNT(j)  (256  + 64 * (j))
#define XB_XSUB(j)  (1280 + 64 * (j))
#define XB_XGEN(j)  (2304 + 64 * (j))
#define XB_TOP      3328
#define XB_TOPGEN   3392
#define XCD_BAR_WORDS 3456
#define XB_SPIN_CAP (1u << 18)
__device__ __forceinline__ unsigned xb_ld(unsigned* p)              { return __hip_atomic_load(p, __ATOMIC_RELAXED, __HIP_MEMORY_SCOPE_AGENT); }
__device__ __forceinline__ unsigned xb_add(unsigned* p, unsigned v) { return __hip_atomic_fetch_add(p, v, __ATOMIC_RELAXED, __HIP_MEMORY_SCOPE_AGENT); }
__device__ __forceinline__ unsigned xb_xcc_id() { return (unsigned)__builtin_amdgcn_s_getreg((3 << 11) | 20) & 0xFu; }
#define XB_SPIN(cond, bar) do { unsigned _sp = 0; while (cond) { __builtin_amdgcn_s_sleep(1); \
    if ((++_sp & 255u) == 0u) { if (xb_ld(&(bar)[XB_TMO])) break; if (_sp > XB_SPIN_CAP) { atomicAdd(&(bar)[XB_TMO], 1u); break; } } } } while (0)
struct XcdBarrier { unsigned* bar; unsigned x; volatile LAS unsigned* st; };
__device__ __forceinline__ XcdBarrier xcd_barrier_post(unsigned* bar, volatile LAS unsigned* st) {
    XcdBarrier b; b.bar = bar; b.x = xb_xcc_id(); b.st = st;
    if (threadIdx.x == 0) (void)xb_add(&bar[XB_XCNT(b.x)], 1u);
    return b;
}
__device__ __forceinline__ void xcd_barrier_complete(unsigned* bar, unsigned x, unsigned& nloc, unsigned& nx) {
    const unsigned G = gridDim.x * gridDim.y * gridDim.z;
    unsigned sum, cnt, mine, sp = 0u;
    for (;;) {
        sum = 0u; cnt = 0u; mine = 0u;
#pragma unroll
        for (unsigned j = 0; j < 16; ++j) { const unsigned c = xb_ld(&bar[XB_XCNT(j)]); sum += c; cnt += (c > 0u) ? 1u : 0u; mine = (j == x) ? c : mine; }
        if (sum == G) break;
        __builtin_amdgcn_s_sleep(1);
        if ((++sp & 255u) == 0u) { if (xb_ld(&bar[XB_TMO])) break; if (sp > XB_SPIN_CAP) { atomicAdd(&bar[XB_TMO], 1u); break; } }
    }
    nloc = mine > 0u ? mine : 1u; nx = cnt > 0u ? cnt : 1u;
}
__device__ __forceinline__ void xcd_barrier(const XcdBarrier& b) {
    asm volatile("s_waitcnt vmcnt(0)" ::: "memory");
    __syncthreads();
    if (threadIdx.x == 0) {
        unsigned* bar = b.bar;
        __builtin_amdgcn_s_waitcnt(0);
        unsigned nloc = b.st[0], nx = b.st[1];
        if (nloc == 0u) { xcd_barrier_complete(bar, b.x, nloc, nx); b.st[0] = nloc; b.st[1] = nx; }
        const unsigned old = xb_add(&bar[XB_XSUB(b.x)], 1u);
        const unsigned gen = old / nloc;
        if (old + 1u == (gen + 1u) * nloc) {
            __builtin_amdgcn_fence(__ATOMIC_RELEASE, "agent");
            asm volatile("s_waitcnt vmcnt(0)" ::: "memory");
            const unsigned og = xb_add(&bar[XB_TOP], 1u);
            const unsigned tg = og / nx;
            if (og + 1u == (tg + 1u) * nx) xb_add(&bar[XB_TOPGEN], 1u);
            else XB_SPIN(xb_ld(&bar[XB_TOPGEN]) == tg, bar);
            __builtin_amdgcn_fence(__ATOMIC_ACQUIRE, "agent");
            xb_add(&bar[XB_XGEN(b.x)], 1u);
            asm volatile("s_waitcnt vmcnt(0)" ::: "memory");
        } else {
            XB_SPIN(xb_ld(&bar[XB_XGEN(b.x)]) == gen, bar);
            __builtin_amdgcn_fence(__ATOMIC_ACQUIRE, "agent");
            asm volatile("s_waitcnt vmcnt(0)" ::: "memory");
        }
    }
    __syncthreads();
}

constexpr size_t MiB = 1u << 20;
constexpr size_t WS_CTL = 0, CTL_ZERO_BYTES = 1 * MiB;
constexpr int CW_BAR = 4096;
constexpr int CW_CNT = 64;
constexpr size_t WS_RSTD1 = 1 * MiB;
constexpr size_t WS_GATES = WS_RSTD1 + 64 * 1024;
constexpr size_t WS_RSTD2 = WS_GATES + 512 * 1024;
constexpr size_t WS_TOKE  = WS_RSTD2 + 64 * 1024;
constexpr size_t WS_TOKP  = WS_TOKE + 256 * 1024;
constexpr size_t WS_TOKG  = WS_TOKP + 256 * 1024;
constexpr size_t WS_LTOK  = 3 * MiB;
constexpr size_t WS_LRS   = 5 * MiB;
constexpr size_t WS_DVEC  = 7 * MiB;
constexpr size_t WS_DN    = 8 * MiB;
constexpr size_t WS_NST   = 8 * MiB + 512 * 1024;
constexpr size_t WS_MSC   = 9 * MiB;
constexpr size_t WS_MST   = 9 * MiB + 64 * 1024;
constexpr size_t WS_WGU   = 16 * MiB;
constexpr size_t WS_WDN   = WS_WGU + 512 * MiB;
constexpr size_t WS_WOUT  = WS_WDN + 256 * MiB;
constexpr size_t WS_X1    = WS_WOUT + 8 * MiB;
constexpr size_t WS_X1B   = WS_X1 + 128 * MiB;
constexpr size_t WS_S0    = WS_X1B + 64 * MiB;
constexpr size_t WS_XB    = WS_S0;
constexpr size_t WS_WIN   = WS_S0 + 64 * MiB;
constexpr size_t WS_PROJ  = WS_S0 + 96 * MiB;
constexpr size_t WS_DS    = WS_S0 + 320 * MiB;
constexpr size_t WS_DC    = WS_S0 + 448 * MiB;
constexpr size_t WS_SST   = WS_S0;
constexpr size_t WS_CST   = WS_S0 + 576 * MiB;
constexpr size_t WS_MIX   = WS_S0 + 640 * MiB;
constexpr size_t WS_ACT   = WS_S0;
constexpr size_t WS_YS    = WS_S0 + 288 * MiB;
constexpr size_t WS_END   = WS_S0 + 704 * MiB;

constexpr int RING_BYTES = 131072;
constexpr int LDSCTL_OFF = 162816;
constexpr int L_MISC = LDSCTL_OFF;
constexpr int L_TILE0 = LDSCTL_OFF + 256;
constexpr int L_CNT = LDSCTL_OFF + 512;
constexpr int L_HIST = LDSCTL_OFF + 768;
constexpr int LDS_BYTES = 163840;

struct Params {
    const float* in[21]; float* out; unsigned char* ws; int ph_lo, ph_hi, li, pad;
};
struct Frame { LAS unsigned char* lds; int tid, lane, wave, G, vcu; };

__device__ __forceinline__ float wave_sum(float v) {
#pragma unroll
    for (int o = 1; o < 64; o <<= 1) v += __shfl_xor(v, o);
    return v;
}

__device__ __forceinline__ void p0_transpose_item(const float* W, int ldw, int k0, int n0, bf16_t* WT, int K, int drow0, const float* sc, LAS float* scr, int lane) {
#pragma unroll 8
    for (int i = 0; i < 32; ++i) { const int kk = 2 * i + (lane >> 5); scr[kk * 33 + (lane & 31)] = W[(size_t)(k0 + kk) * ldw + n0 + (lane & 31)]; }
    const int c = lane & 7;
    float s8[8];
#pragma unroll
    for (int j = 0; j < 8; ++j) s8[j] = sc ? sc[k0 + 8 * c + j] : 1.0f;
    asm volatile("s_waitcnt lgkmcnt(0)" ::: "memory");
#pragma unroll
    for (int j = 0; j < 4; ++j) { const int n = (lane >> 3) + 8 * j; const LAS float* s = scr + (8 * c) * 33 + n;
        u32x4 o; o.x = cvt_pk_bf16(s[0 * 33] * s8[0], s[1 * 33] * s8[1]); o.y = cvt_pk_bf16(s[2 * 33] * s8[2], s[3 * 33] * s8[3]); o.z = cvt_pk_bf16(s[4 * 33] * s8[4], s[5 * 33] * s8[5]); o.w = cvt_pk_bf16(s[6 * 33] * s8[6], s[7 * 33] * s8[7]);
        *(u32x4*)(WT + (size_t)(drow0 + n) * K + k0 + 8 * c) = o; }
    asm volatile("s_waitcnt lgkmcnt(0)" ::: "memory");
}

__device__ __forceinline__ void p0_transpose_item_bf16(const float* W, int ldw, int k0, int n0, bf16_t* WT, int K, int drow0, const float* sc, LAS unsigned char* tile, int lane) {
    const int kq = lane >> 4, nq = lane & 15;
    const float* src = W + (size_t)(k0 + 4 * kq) * ldw + n0 + 4 * nq;
#pragma unroll
    for (int hb = 0; hb < 2; ++hb) {
        f32x4 v[4][4], sv[4];
        const float* scp = sc ? sc + k0 + 64 * hb + 4 * kq : src;
#pragma unroll
        for (int i = 0; i < 4; ++i) sv[i] = *(const f32x4*)(scp + (sc ? 16 * i : 0));
#pragma unroll
        for (int i = 0; i < 4; ++i)
#pragma unroll
            for (int j = 0; j < 4; ++j) v[i][j] = *(const f32x4*)(src + (size_t)(64 * hb + 16 * i + j) * ldw);
#pragma unroll
        for (int i = 0; i < 4; ++i) {
            const f32x4 s4 = sc ? sv[i] : (f32x4){1.f, 1.f, 1.f, 1.f};
#pragma unroll
            for (int nn = 0; nn < 4; ++nn) { u32x2 t; t.x = cvt_pk_bf16(v[i][0][nn] * s4[0], v[i][1][nn] * s4[1]); t.y = cvt_pk_bf16(v[i][2][nn] * s4[2], v[i][3][nn] * s4[3]);
                const int chunk = 2 * (4 * hb + i) + (kq >> 1);
                *(LAS u32x2*)(tile + (4 * nq + nn) * 256 + ((chunk ^ nq) << 4) + ((kq & 1) << 3)) = t; }
        }
    }
    asm volatile("s_waitcnt lgkmcnt(0)" ::: "memory");
#pragma unroll
    for (int r = 0; r < 16; ++r) { const int n = (lane >> 4) + 4 * r, c = lane & 15;
        const u32x4 o = *(const LAS u32x4*)(tile + n * 256 + ((c ^ ((n >> 2) & 15)) << 4));
        *(u32x4*)(WT + (size_t)(drow0 + n) * K + k0 + 8 * c) = o; }
    asm volatile("s_waitcnt lgkmcnt(0)" ::: "memory");
}

struct ConvItem { const float* W; unsigned char* WT; int sco; int k0, n0, drow0; };
__device__ __forceinline__ ConvItem conv_item(const Params& p, int it) {
    constexpr int I_E = (DM / 128) * (DFF / 64);
    const bool dn = it >= NEXP * 2 * I_E; const int j = dn ? it - NEXP * 2 * I_E : it;
    const int e = dn ? j / I_E : j / (2 * I_E), which = dn ? 2 : (j % (2 * I_E)) / I_E, r3 = j % I_E, nb = r3 % (DFF / 64), kb = r3 / (DFF / 64), n0 = nb * 64;
    ConvItem c; c.k0 = kb * 128; c.n0 = n0;
    if (which == 0) { c.W = p.in[14] + (size_t)e * DM * DFF; c.WT = (unsigned char*)(p.ws + WS_WGU) + (size_t)e * 4096 * DM; c.sco = 0; c.drow0 = (n0 >> 7) * 256 + (n0 & 127); }
    else if (which == 1) { c.W = p.in[16] + (size_t)e * DM * DFF; c.WT = (unsigned char*)(p.ws + WS_WGU) + (size_t)e * 4096 * DM; c.sco = 0; c.drow0 = (n0 >> 7) * 256 + 128 + (n0 & 127); }
    else { c.W = p.in[18] + (size_t)e * DFF * DM; c.WT = (unsigned char*)(p.ws + WS_WDN) + (size_t)e * DM * DFF; c.sco = 8192; c.drow0 = n0; }
    return c;
}
#define CONV_LOAD(dst, ci, half) do { const float* src_ = (ci).W + (size_t)((ci).k0 + 64 * (half) + 4 * kq) * 2048 + (ci).n0 + 4 * nq; \
        _Pragma("unroll") for (int i_ = 0; i_ < 4; ++i_) _Pragma("unroll") for (int j_ = 0; j_ < 4; ++j_) dst[i_][j_] = __builtin_nontemporal_load((const f32x4*)(src_ + (size_t)(16 * i_ + j_) * 2048)); } while (0)
#define CONV_PACK(srcv, ci, half) do { _Pragma("unroll") for (int i_ = 0; i_ < 4; ++i_) { \
        const f32x4 s4_ = *(const LAS f32x4*)(F.lds + (ci).sco + ((ci).k0 + 64 * (half) + 16 * i_ + 4 * kq) * 4); \
        _Pragma("unroll") for (int nn_ = 0; nn_ < 4; ++nn_) { const unsigned t_ = cvt4_fp8(srcv[i_][0][nn_] * s4_[0], srcv[i_][1][nn_] * s4_[1], srcv[i_][2][nn_] * s4_[2], srcv[i_][3][nn_] * s4_[3]); \
            const int n_ = 4 * nq + nn_, d_ = (4 * (4 * (half) + i_) + kq) ^ (4 * (nq & 7)); *(LAS unsigned*)(tile + n_ * 128 + d_ * 4) = t_; } } } while (0)
#define CONV_STORE(ci) do { asm volatile("s_waitcnt lgkmcnt(0)" ::: "memory"); \
        _Pragma("unroll") for (int r_ = 0; r_ < 8; ++r_) { const int n_ = (lane >> 3) + 8 * r_, c_ = lane & 7; const u32x4 o_ = *(const LAS u32x4*)(tile + n_ * 128 + 16 * (c_ ^ ((n_ >> 2) & 7))); \
            __builtin_nontemporal_store(o_, (u32x4*)((ci).WT + (size_t)((ci).drow0 + n_) * 2048 + (ci).k0 + 16 * c_)); } \
        asm volatile("s_waitcnt lgkmcnt(0)" ::: "memory"); } while (0)
__device__ __forceinline__ void moe_weight_convert(const Params& p, Frame& F, int gw, int NGW, int it0, int NIT) {
    LAS unsigned char* tile = F.lds + 16384 + F.wave * 8192;
    const int lane = F.lane, kq = lane >> 4, nq = lane & 15;
    __syncthreads();
    for (int i = F.tid; i < DM; i += 512) { *(LAS float*)(F.lds + 4 * i) = p.in[11][i] * 64.0f; *(LAS float*)(F.lds + 8192 + 4 * i) = 64.0f; }
    __syncthreads();
    int it = it0 + gw; if (it >= NIT) return;
    ConvItem cur = conv_item(p, it);
    f32x4 va[4][4], vb[4][4];
    CONV_LOAD(va, cur, 0);
    for (;;) {
        CONV_LOAD(vb, cur, 1);
        CONV_PACK(va, cur, 0);
        const int nit = it + NGW; const bool more = nit < NIT;
        const ConvItem nxt = conv_item(p, more ? nit : it);
        CONV_LOAD(va, nxt, 0);
        CONV_PACK(vb, cur, 1);
        CONV_STORE(cur);
        if (!more) break;
        cur = nxt; it = nit;
    }
}
#undef CONV_LOAD
#undef CONV_PACK
#undef CONV_STORE

template <int MODE>
__device__ __forceinline__ void skinny_f32(const float* X, int r0, int kbeg, const float* W, const float* lnw, bf16_t* XB, f32x16& acc, float& ssq, int lane) {
    const int m = lane & 31, kk = lane >> 5;
    const float* xr = X + (size_t)(r0 + m) * DM;
    ssq = 0.f;
    f32x4 a[4], lw[4], na[4], nlw[4]; float b[16], nb[16];
#define SK_LOAD(A_, LW_, B_, kb_) do { const int k0_ = (kb_) + 16 * kk; \
        _Pragma("unroll") for (int j_ = 0; j_ < 4; ++j_) { A_[j_] = *(const f32x4*)(xr + k0_ + 4 * j_); LW_[j_] = *(const f32x4*)(lnw + k0_ + 4 * j_); } \
        _Pragma("unroll") for (int j_ = 0; j_ < 16; ++j_) { if (MODE == 0) B_[j_] = (m < 8) ? W[(size_t)(k0_ + j_) * D_IN + NPROJ + m] : 0.f; else B_[j_] = W[(size_t)(k0_ + j_) * NEXP + m]; } } while (0)
    SK_LOAD(a, lw, b, kbeg);
#pragma unroll 1
    for (int kb = kbeg; kb < kbeg + 512; kb += 32) {
        const int k0 = kb + 16 * kk;
        if (kb + 32 < kbeg + 512) SK_LOAD(na, nlw, nb, kb + 32);
#pragma unroll
        for (int j = 0; j < 4; ++j) ssq += (a[j][0] * a[j][0] + a[j][1] * a[j][1]) + (a[j][2] * a[j][2] + a[j][3] * a[j][3]);
        if (MODE == 0) {
            u32x4 q0, q1;
            q0.x = cvt_pk_bf16(b[0] * lw[0][0], b[1] * lw[0][1]); q0.y = cvt_pk_bf16(b[2] * lw[0][2], b[3] * lw[0][3]); q0.z = cvt_pk_bf16(b[4] * lw[1][0], b[5] * lw[1][1]); q0.w = cvt_pk_bf16(b[6] * lw[1][2], b[7] * lw[1][3]);
            q1.x = cvt_pk_bf16(b[8] * lw[2][0], b[9] * lw[2][1]); q1.y = cvt_pk_bf16(b[10] * lw[2][2], b[11] * lw[2][3]); q1.z = cvt_pk_bf16(b[12] * lw[3][0], b[13] * lw[3][1]); q1.w = cvt_pk_bf16(b[14] * lw[3][2], b[15] * lw[3][3]);
            u32x4 w0, w1; w0.x = cvt_pk_bf16(a[0][0], a[0][1]); w0.y = cvt_pk_bf16(a[0][2], a[0][3]); w0.z = cvt_pk_bf16(a[1][0], a[1][1]); w0.w = cvt_pk_bf16(a[1][2], a[1][3]);
            w1.x = cvt_pk_bf16(a[2][0], a[2][1]); w1.y = cvt_pk_bf16(a[2][2], a[2][3]); w1.z = cvt_pk_bf16(a[3][0], a[3][1]); w1.w = cvt_pk_bf16(a[3][2], a[3][3]);
            bf16_t* o = XB + (size_t)(r0 + m) * DM + k0; *(u32x4*)o = w0; *(u32x4*)(o + 8) = w1;
            acc = __builtin_amdgcn_mfma_f32_32x32x16_bf16(__builtin_bit_cast(bf16x8, w0), __builtin_bit_cast(bf16x8, q0), acc, 0, 0, 0);
            acc = __builtin_amdgcn_mfma_f32_32x32x16_bf16(__builtin_bit_cast(bf16x8, w1), __builtin_bit_cast(bf16x8, q1), acc, 0, 0, 0);
        } else {
#pragma unroll
            for (int j = 0; j < 16; ++j) acc = __builtin_amdgcn_mfma_f32_32x32x2f32(a[j >> 2][j & 3], b[j] * lw[j >> 2][j & 3], acc, 0, 0, 0);
        }
#pragma unroll
        for (int j = 0; j < 4; ++j) { a[j] = na[j]; lw[j] = nlw[j]; }
#pragma unroll
        for (int j = 0; j < 16; ++j) b[j] = nb[j];
    }
#undef SK_LOAD
    ssq += __shfl_xor(ssq, 32);
}

__device__ __forceinline__ void p0_prologue(const Params& p, Frame& F) {
    unsigned char* ws = p.ws;
    {
        LAS float* part = (LAS float*)(F.lds);
        LAS float* ssqp = (LAS float*)(F.lds + 8192);
        const float* x = p.in[0]; const float* ln1 = p.in[1]; const float* win = p.in[2];
        bf16_t* xb = (bf16_t*)(ws + WS_XB);
        for (int blk = F.vcu; blk < T_TOK / 64; blk += F.G) {
            const int g = F.wave >> 2, ks = F.wave & 3, r0 = blk * 64 + g * 32;
            f32x16 acc;
#pragma unroll
            for (int i = 0; i < 16; ++i) acc[i] = 0.f;
            float ssq;
            skinny_f32<0>(x, r0, ks * 512, win, ln1, xb, acc, ssq, F.lane);
            const int n = F.lane & 31, hh = F.lane >> 5;
            if (n < 8) {
#pragma unroll
                for (int i = 0; i < 16; ++i) { const int row = (i & 3) + 8 * (i >> 2) + 4 * hh; part[((g * 4 + ks) * 32 + row) * 8 + n] = acc[i]; }
            }
            if (F.lane < 32) ssqp[(g * 4 + ks) * 32 + F.lane] = ssq;
            __syncthreads();
            if (F.tid < 64) {
                const int gg = F.tid >> 5, mm = F.tid & 31, t = blk * 64 + F.tid;
                float s = 0.f;
#pragma unroll
                for (int q = 0; q < 4; ++q) s += ssqp[(gg * 4 + q) * 32 + mm];
                const float rs = 1.0f / sqrtf(s * (1.0f / DM) + EPS);
                ((float*)(ws + WS_RSTD1))[t] = rs;
                float gt[8];
#pragma unroll
                for (int nn = 0; nn < 8; ++nn) { float v = 0.f;
#pragma unroll
                    for (int q = 0; q < 4; ++q) v += part[((gg * 4 + q) * 32 + mm) * 8 + nn];
                    gt[nn] = v * rs; }
                float* go = (float*)(ws + WS_GATES) + (size_t)t * 8;
                float bi[4], bf[4];
#pragma unroll
                for (int h = 0; h < 4; ++h) { bi[h] = p.in[7][h]; bf[h] = p.in[8][h]; }
                f32x4 o0, o1;
#pragma unroll
                for (int h = 0; h < 4; ++h) { o0[h] = gt[h] + bi[h]; const float f = gt[4 + h] + bf[h];
                    o1[h] = fminf(f, 0.f) - log1pf(__expf(-fabsf(f))); }
                *(f32x4*)go = o0; *(f32x4*)(go + 4) = o1;
            }
            __syncthreads();
        }
    }
    {
        LAS unsigned char* tile = F.lds + 16384 + F.wave * 16384;
        const int gw = F.vcu * 8 + F.wave, NGW = F.G * 8;
        constexpr int KB = DM / 128;
        constexpr int I_IN = KB * (NPROJ / 64), I_OUT = KB * (DM / 64);
        const float* ln1 = p.in[1];
        (void)I_OUT;
        for (int it = gw; it < I_IN; it += NGW) {
            const int nb = it % (NPROJ / 64), kb = it / (NPROJ / 64); p0_transpose_item_bf16(p.in[2], D_IN, kb * 128, nb * 64, (bf16_t*)(ws + WS_WIN), DM, nb * 64, ln1, tile, F.lane);
        }
    }
}
__device__ __forceinline__ void wout_transpose(const Params& p, Frame& F, int gw, int NGW) {
    LAS unsigned char* tile = F.lds + 16384 + F.wave * 16384;
    __syncthreads();
    for (int it = gw; it < (DM / 128) * (DM / 64); it += NGW) {
        const int nb = it % (DM / 64), kb = it / (DM / 64); p0_transpose_item_bf16(p.in[10], DM, kb * 128, nb * 64, (bf16_t*)(p.ws + WS_WOUT), DM, nb * 64, nullptr, tile, F.lane);
    }
    __syncthreads();
}

#define LBAR() do { asm volatile("s_waitcnt lgkmcnt(0)" ::: "memory"); __builtin_amdgcn_s_barrier(); asm volatile("" ::: "memory"); } while (0)
#define VLBAR() do { asm volatile("s_waitcnt vmcnt(0) lgkmcnt(0)" ::: "memory"); __builtin_amdgcn_s_barrier(); asm volatile("" ::: "memory"); } while (0)
template <int LPR>
__device__ __forceinline__ void dma_rows(LAS unsigned char* dst, const bf16_t* src, size_t gstride, int ninstr, int wave, int lane) {
    constexpr int RPI = 64 / LPR;
    asm volatile("" : "+v"(lane));
    for (int i = wave; i < ninstr; i += 8) { const int row = i * RPI + lane / LPR, c = lane % LPR;
        __builtin_amdgcn_global_load_lds((const unsigned*)(src + (size_t)row * gstride + c * 8), (LAS unsigned*)(dst + i * 1024), 16, 0, 0); }
}
__device__ __forceinline__ bf16x8 lds_frag(const LAS bf16_t* base, int row, int stride, int kofs) { return *(const LAS bf16x8*)(base + row * stride + kofs); }
__device__ __forceinline__ bf16_t f2bf(float v) { return (bf16_t)(cvt_pk_bf16(v, 0.f) & 0xffffu); }
__device__ __forceinline__ void hg_gate(float z, float lb, float& lf, float& kk) { const float f = lb + (1.0f - lb) * sigmoidf_(z); lf = __logf(f); kk = 1.0f - f; }

constexpr int TS = 136;
constexpr int TT = 72;

__device__ __forceinline__ void hg_local_phase(const Params& p, Frame& F) {
    unsigned char* ws = p.ws; const int tid = F.tid, lane = F.lane, w = F.wave;
    LAS bf16_t* KdT = (LAS bf16_t*)(F.lds + 65536); LAS bf16_t* VT = (LAS bf16_t*)(F.lds + 83968);
    LAS float* seg = (LAS float*)(F.lds + 102400);
#define HGL_ISSUE(it_, set_) do { const int sh_ = (it_) >> 7, c_ = (it_) & 127, b_ = sh_ >> 3, h_ = sh_ & 7; const bf16_t* pj_ = (const bf16_t*)(ws + WS_PROJ) + ((size_t)b_ * SEQ + (size_t)c_ * 64) * NPROJ; \
        dma_rows<16>(F.lds + (set_) * 32768, pj_ + C_HF + h_ * 128, NPROJ, 16, w, lane); dma_rows<16>(F.lds + (set_) * 32768 + 16384, pj_ + C_HI + h_ * 128, NPROJ, 16, w, lane); \
        nl0 = p.in[3][h_ * 128 + (tid & 127)]; nl1 = p.in[3][1024 + h_ * 128 + (tid & 127)]; } while (0)
    float nl0 = 0.f, nl1 = 0.f;
    LBAR();
    int item = F.vcu, set = 0;
    if (item < 2048) HGL_ISSUE(item, 0);
    asm volatile("s_waitcnt vmcnt(0)" ::: "memory");
    for (; item < 2048; item += F.G, set ^= 1) {
        const float l0 = nl0, l1 = nl1;
        LBAR();
        if (item + F.G < 2048) HGL_ISSUE(item + F.G, set ^ 1);
        const LAS bf16_t* ZR = (const LAS bf16_t*)(F.lds + set * 32768); const LAS bf16_t* VR = (const LAS bf16_t*)(F.lds + set * 32768 + 16384);
        const int k = tid & 127, tq = w >> 1;
        const float lb = 1.0f / (1.0f + __expf(l1 - l0));
        float cs[16], kk[16]; float run = 0.f;
#pragma unroll
        for (int j = 0; j < 16; ++j) { float lf; hg_gate(bf2f(ZR[(16 * tq + j) * 128 + k]), lb, lf, kk[j]); run += lf; cs[j] = run; }
        seg[tq * 128 + k] = run;
        { unsigned pk[8];
#pragma unroll
          for (int j = 0; j < 8; ++j) pk[j] = (unsigned)VR[(16 * tq + 2 * j) * 128 + k] | ((unsigned)VR[(16 * tq + 2 * j + 1) * 128 + k] << 16);
          *(LAS u32x4*)(VT + k * TT + 16 * tq) = (u32x4){pk[0], pk[1], pk[2], pk[3]}; *(LAS u32x4*)(VT + k * TT + 16 * tq + 8) = (u32x4){pk[4], pk[5], pk[6], pk[7]}; }
        LBAR();
        float off = 0.f, tot = 0.f;
#pragma unroll
        for (int q = 0; q < 4; ++q) { const float s = seg[q * 128 + k]; tot += s; if (q < tq) off += s; }
        { unsigned pk[8];
#pragma unroll
          for (int j = 0; j < 8; ++j) pk[j] = cvt_pk_bf16(kk[2 * j] * __expf(tot - (off + cs[2 * j])), kk[2 * j + 1] * __expf(tot - (off + cs[2 * j + 1])));
          *(LAS u32x4*)(KdT + k * TT + 16 * tq) = (u32x4){pk[0], pk[1], pk[2], pk[3]}; *(LAS u32x4*)(KdT + k * TT + 16 * tq + 8) = (u32x4){pk[4], pk[5], pk[6], pk[7]}; }
        const float dve = __expf(tot);
        LBAR();
        const int fr = lane & 15, fq = lane >> 4;
        bf16x8 bv[2];
#pragma unroll
        for (int ks = 0; ks < 2; ++ks) bv[ks] = lds_frag(VT, 16 * w + fr, TT, 32 * ks + 8 * fq);
        u32x2 o[8];
#pragma unroll
        for (int kb = 0; kb < 8; ++kb) { f32x4 acc = (f32x4){0.f, 0.f, 0.f, 0.f};
#pragma unroll
            for (int ks = 0; ks < 2; ++ks) acc = __builtin_amdgcn_mfma_f32_16x16x32_bf16(lds_frag(KdT, 16 * kb + fr, TT, 32 * ks + 8 * fq), bv[ks], acc, 0, 0, 0);
            o[kb].x = cvt_pk_bf16(acc[0], acc[1]); o[kb].y = cvt_pk_bf16(acc[2], acc[3]); }
        asm volatile("s_waitcnt vmcnt(0)" ::: "memory");
        bf16_t* dS = (bf16_t*)(ws + WS_DS) + ((size_t)((item >> 7) * 128 + 16 * w + fr) * 128 + (item & 127)) * 128 + 4 * fq;
#pragma unroll
        for (int kb = 0; kb < 8; ++kb) *(u32x2*)(dS + 16 * kb) = o[kb];
        if (tq == 0) ((float*)(ws + WS_DVEC))[(size_t)item * 128 + k] = dve;
    }
#undef HGL_ISSUE
}

__device__ __forceinline__ void ml_local_phase(const Params& p, Frame& F) {
    unsigned char* ws = p.ws; const int tid = F.tid, lane = F.lane, w = F.wave;
    LAS bf16_t* KT = (LAS bf16_t*)(F.lds + 100352); LAS bf16_t* VT = (LAS bf16_t*)(F.lds + 118784);
    LAS float* nred = (LAS float*)(F.lds + 155648);
    float nli = 0.f, nlf = 0.f;
#define MLL_ISSUE(it_, set_) do { const int sh_ = (it_) >> 7, c_ = (it_) & 127, b_ = sh_ >> 2, h_ = sh_ & 3; const size_t t0_ = (size_t)b_ * SEQ + (size_t)c_ * 64; const bf16_t* pj_ = (const bf16_t*)(ws + WS_PROJ) + t0_ * NPROJ; \
        dma_rows<16>(F.lds + (set_) * 50176, pj_ + C_MK + h_ * 128 - 3 * (size_t)NPROJ, NPROJ, 17, w, lane); dma_rows<32>(F.lds + (set_) * 50176 + 17408, pj_ + C_MV + h_ * 256, NPROJ, 32, w, lane); \
        const float* gt_ = (const float*)(ws + WS_GATES) + (t0_ + lane) * 8; nli = gt_[h_]; nlf = gt_[4 + h_]; \
        { const int ch_ = 512 + h_ * 128 + (tid & 127); ncw[0] = p.in[5][ch_]; ncw[1] = p.in[5][1024 + ch_]; ncw[2] = p.in[5][2048 + ch_]; ncw[3] = p.in[5][3072 + ch_]; ncw[4] = p.in[6][ch_]; } } while (0)
    float ncw[5] = {0.f, 0.f, 0.f, 0.f, 0.f};
    LBAR();
    int item = F.vcu, set = 0;
    if (item < 1024) MLL_ISSUE(item, 0);
    asm volatile("s_waitcnt vmcnt(0)" ::: "memory");
    for (; item < 1024; item += F.G, set ^= 1) {
        const int c = item & 127;
        const float li = nli, lf = nlf, w0 = ncw[0], w1 = ncw[1], w2 = ncw[2], w3 = ncw[3], cb = ncw[4];
        LBAR();
        if (item + F.G < 1024) MLL_ISSUE(item + F.G, set ^ 1);
        const LAS bf16_t* KR = (const LAS bf16_t*)(F.lds + set * 50176); const LAS bf16_t* VR = (const LAS bf16_t*)(F.lds + set * 50176 + 17408);
        float g = lf;
#pragma unroll
        for (int o = 1; o < 64; o <<= 1) { const float v = __shfl_up(g, o); if (lane >= o) g += v; }
        const float glast = __shfl(g, 63), lws = glast - g + li;
        float mx = lws;
#pragma unroll
        for (int o = 1; o < 64; o <<= 1) mx = fmaxf(mx, __shfl_xor(mx, o));
        const float wsl = __expf(lws - mx);
        { const int v = tid & 255, hf = tid >> 8; unsigned pk[16];
#pragma unroll
          for (int j = 0; j < 16; ++j) pk[j] = (unsigned)VR[(32 * hf + 2 * j) * 256 + v] | ((unsigned)VR[(32 * hf + 2 * j + 1) * 256 + v] << 16);
#pragma unroll
          for (int q = 0; q < 4; ++q) *(LAS u32x4*)(VT + v * TT + 32 * hf + 8 * q) = (u32x4){pk[4 * q], pk[4 * q + 1], pk[4 * q + 2], pk[4 * q + 3]}; }
        { const int d = tid & 127, tq = w >> 1;
          float r[19];
#pragma unroll
          for (int j = 0; j < 19; ++j) { const float v = bf2f(KR[(16 * tq + j) * 128 + d]); r[j] = (c == 0 && 16 * tq + j < 3) ? 0.f : v; }
          float kw[16]; float ns = 0.f;
#pragma unroll
          for (int j = 0; j < 16; ++j) { const float a = cb + w0 * r[j] + w1 * r[j + 1] + w2 * r[j + 2] + w3 * r[j + 3];
              const float wv = __uint_as_float(__builtin_amdgcn_readlane(__float_as_uint(wsl), 16 * tq + j)); kw[j] = a * sigmoidf_(a) * wv; ns += kw[j]; }
          unsigned pk[8];
#pragma unroll
          for (int j = 0; j < 8; ++j) pk[j] = cvt_pk_bf16(kw[2 * j], kw[2 * j + 1]);
          *(LAS u32x4*)(KT + d * TT + 16 * tq) = (u32x4){pk[0], pk[1], pk[2], pk[3]}; *(LAS u32x4*)(KT + d * TT + 16 * tq + 8) = (u32x4){pk[4], pk[5], pk[6], pk[7]};
          nred[tq * 128 + d] = ns; }
        LBAR();
        const float dnv = (tid < 128) ? (nred[tid] + nred[128 + tid]) + (nred[256 + tid] + nred[384 + tid]) : 0.f;
        const int fr = lane & 15, fq = lane >> 4;
        u32x2 o[2][8];
#pragma unroll
        for (int mb = 0; mb < 2; ++mb) {
            bf16x8 bv[2];
#pragma unroll
            for (int ks = 0; ks < 2; ++ks) bv[ks] = lds_frag(VT, 32 * w + 16 * mb + fr, TT, 32 * ks + 8 * fq);
#pragma unroll
            for (int db = 0; db < 8; ++db) { f32x4 acc = (f32x4){0.f, 0.f, 0.f, 0.f};
#pragma unroll
                for (int ks = 0; ks < 2; ++ks) acc = __builtin_amdgcn_mfma_f32_16x16x32_bf16(lds_frag(KT, 16 * db + fr, TT, 32 * ks + 8 * fq), bv[ks], acc, 0, 0, 0);
                o[mb][db].x = cvt_pk_bf16(acc[0], acc[1]); o[mb][db].y = cvt_pk_bf16(acc[2], acc[3]); }
        }
        asm volatile("s_waitcnt vmcnt(0)" ::: "memory");
#pragma unroll
        for (int mb = 0; mb < 2; ++mb) { bf16_t* dC = (bf16_t*)(ws + WS_DC) + ((size_t)((item >> 7) * 256 + 32 * w + 16 * mb + fr) * 128 + (item & 127)) * 128 + 4 * fq;
#pragma unroll
            for (int db = 0; db < 8; ++db) *(u32x2*)(dC + 16 * db) = o[mb][db]; }
        if (tid < 128) ((float*)(ws + WS_DN))[(size_t)item * 128 + tid] = dnv;
        if (tid == 0) { float* ms = (float*)(ws + WS_MSC) + (size_t)item * 4; ms[0] = glast; ms[1] = mx; }
    }
#undef MLL_ISSUE
}

__device__ __forceinline__ void p2_scan(const Params& p, Frame& F) {
    unsigned char* ws = p.ws;
    for (int gid = F.vcu * 512 + F.tid; gid < 131072; gid += F.G * 512) {
        if (gid < 65536) {
            const int sh = gid >> 12, rem = gid & 4095;
            const bf16_t* dS = (const bf16_t*)(ws + WS_DS) + (size_t)(sh * 128 + (rem >> 5)) * 16384 + (rem & 31) * 4;
            const float* dv = (const float*)(ws + WS_DVEC) + (size_t)sh * 128 * 128 + (rem & 31) * 4;
            bf16_t* so = (bf16_t*)(ws + WS_SST) + (size_t)sh * 128 * 16384 + rem * 4;
            f32x4 run = (f32x4){0.f, 0.f, 0.f, 0.f};
#pragma unroll 1
            for (int cb = 0; cb < NCHUNK; cb += 16) {
                u32x2 d[16]; f32x4 de[16];
#pragma unroll
                for (int j = 0; j < 16; ++j) { d[j] = *(const u32x2*)(dS + (size_t)(cb + j) * 128); de[j] = *(const f32x4*)(dv + (cb + j) * 128); }
#pragma unroll
                for (int j = 0; j < 16; ++j) {
                    u32x2 o; o.x = cvt_pk_bf16(run[0], run[1]); o.y = cvt_pk_bf16(run[2], run[3]);
                    *(u32x2*)(so + (size_t)(cb + j) * 16384) = o;
                    run = de[j] * run + (f32x4){bflo(d[j].x), bfhi(d[j].x), bflo(d[j].y), bfhi(d[j].y)};
                }
            }
        } else {
            const int g2 = gid - 65536, sh = g2 >> 13, rem = g2 & 8191;
            const bf16_t* dC = (const bf16_t*)(ws + WS_DC) + (size_t)(sh * 256 + (rem >> 5)) * 16384 + (rem & 31) * 4;
            const float* ms = (const float*)(ws + WS_MSC) + (size_t)sh * 128 * 4;
            bf16_t* co = (bf16_t*)(ws + WS_CST) + (size_t)sh * 128 * 32768 + rem * 4;
            const bool do_n = (rem < 32);
            const float* dn = (const float*)(ws + WS_DN) + (size_t)sh * 128 * 128 + (rem & 31) * 4;
            float* nst = (float*)(ws + WS_NST) + (size_t)sh * 128 * 128 + (rem & 31) * 4;
            float* mso = (float*)(ws + WS_MST) + (size_t)sh * 128;
            f32x4 run = (f32x4){0.f, 0.f, 0.f, 0.f}, nrun = (f32x4){0.f, 0.f, 0.f, 0.f}; float m = 0.f;
#pragma unroll 1
            for (int cb = 0; cb < NCHUNK; cb += 16) {
                u32x2 d[16]; float gl[16], ml[16]; f32x4 dnv[16];
#pragma unroll
                for (int j = 0; j < 16; ++j) { d[j] = *(const u32x2*)(dC + (size_t)(cb + j) * 128); gl[j] = ms[(cb + j) * 4]; ml[j] = ms[(cb + j) * 4 + 1]; }
#pragma unroll
                for (int j = 0; j < 16; ++j) dnv[j] = (f32x4){0.f, 0.f, 0.f, 0.f};
                if (do_n) {
#pragma unroll
                    for (int j = 0; j < 16; ++j) dnv[j] = *(const f32x4*)(dn + (cb + j) * 128);
                }
#pragma unroll
                for (int j = 0; j < 16; ++j) { const int c = cb + j;
                    const float mn = fmaxf(gl[j] + m, ml[j]), dec = __expf(gl[j] + m - mn), sl = __expf(ml[j] - mn);
                    u32x2 o; o.x = cvt_pk_bf16(run[0], run[1]); o.y = cvt_pk_bf16(run[2], run[3]);
                    *(u32x2*)(co + (size_t)c * 32768) = o;
                    if (do_n) { *(f32x4*)(nst + c * 128) = nrun; nrun = dec * nrun + sl * dnv[j]; if (rem == 0) mso[c] = m; }
                    run = dec * run + sl * (f32x4){bflo(d[j].x), bfhi(d[j].x), bflo(d[j].y), bfhi(d[j].y)}; m = mn;
                }
            }
        }
    }
}

__device__ __forceinline__ void hg_out_phase(const Params& p, Frame& F) {
    unsigned char* ws = p.ws; const int tid = F.tid, lane = F.lane, w = F.wave;
    LAS bf16_t* GR = (LAS bf16_t*)(F.lds + 98304); LAS bf16_t* VT = (LAS bf16_t*)(F.lds + 114688);
    LAS bf16_t* ATT = (LAS bf16_t*)(F.lds + 133120) + w * (16 * TT); LAS float* seg = (LAS float*)(F.lds + 151552); LAS float* ssqp = (LAS float*)(F.lds + 153600);
#define HGO_ISSUE_QZV(it_, set_) do { const int sh_ = (it_) >> 7, c_ = (it_) & 127, b_ = sh_ >> 3, h_ = sh_ & 7; const bf16_t* pj_ = (const bf16_t*)(ws + WS_PROJ) + ((size_t)b_ * SEQ + (size_t)c_ * 64) * NPROJ; \
        dma_rows<16>(F.lds + (set_) * 49152, pj_ + C_HQ + h_ * 128, NPROJ, 16, w, lane); dma_rows<16>(F.lds + (set_) * 49152 + 16384, pj_ + C_HF + h_ * 128, NPROJ, 16, w, lane); \
        dma_rows<16>(F.lds + (set_) * 49152 + 32768, pj_ + C_HI + h_ * 128, NPROJ, 16, w, lane); \
        nl0 = p.in[3][h_ * 128 + (tid & 127)]; nl1 = p.in[3][1024 + h_ * 128 + (tid & 127)]; \
        _Pragma("unroll") for (int nb_ = 0; nb_ < 4; ++nb_) nnw[nb_] = p.in[4][h_ * 128 + 16 * (4 * vh + nb_) + fr]; } while (0)
#define HGO_ISSUE_G(it_) do { const int sh_ = (it_) >> 7, c_ = (it_) & 127, b_ = sh_ >> 3, h_ = sh_ & 7; const bf16_t* pj_ = (const bf16_t*)(ws + WS_PROJ) + ((size_t)b_ * SEQ + (size_t)c_ * 64) * NPROJ; \
        dma_rows<16>((LAS unsigned char*)GR, pj_ + C_HG + h_ * 128, NPROJ, 16, w, lane); } while (0)
    const int fr = lane & 15, fq = lane >> 4, tb = w & 3, vh = w >> 2;
    float nl0 = 0.f, nl1 = 0.f, nnw[4] = {0.f, 0.f, 0.f, 0.f};
    LBAR();
    int item = F.vcu, set = 0;
    if (item < 2048) { HGO_ISSUE_QZV(item, 0); HGO_ISSUE_G(item); }
    asm volatile("s_waitcnt vmcnt(0)" ::: "memory");
    for (; item < 2048; item += F.G, set ^= 1) {
        const int sh = item >> 7, c = item & 127, b = sh >> 3, h = sh & 7; const size_t t0 = (size_t)b * SEQ + (size_t)c * 64;
        const float l0 = nl0, l1 = nl1, nw0 = nnw[0], nw1 = nnw[1], nw2 = nnw[2], nw3 = nnw[3];
        LBAR();
        if (item + F.G < 2048) HGO_ISSUE_QZV(item + F.G, set ^ 1);
        LAS bf16_t* QR = (LAS bf16_t*)(F.lds + set * 49152); LAS bf16_t* ZR = QR + 8192; LAS bf16_t* VR = QR + 16384;
        bf16x8 stf[4][4];
        { const bf16_t* ST = (const bf16_t*)(ws + WS_SST) + (size_t)item * 16384;
#pragma unroll
          for (int nb = 0; nb < 4; ++nb)
#pragma unroll
              for (int ks = 0; ks < 4; ++ks) stf[nb][ks] = *(const bf16x8*)(ST + (size_t)(16 * (4 * vh + nb) + fr) * 128 + 32 * ks + 8 * fq); }
        __builtin_amdgcn_sched_barrier(0);
        const int k = tid & 127, tq = w >> 1;
        const float lb = 1.0f / (1.0f + __expf(l1 - l0));
        float cs[16], kk[16], rq[16]; float run = 0.f;
#pragma unroll
        for (int j = 0; j < 16; ++j) { float lf; hg_gate(bf2f(ZR[(16 * tq + j) * 128 + k]), lb, lf, kk[j]); run += lf; cs[j] = run; rq[j] = bf2f(QR[(16 * tq + j) * 128 + k]); }
        seg[tq * 128 + k] = run;
        { unsigned pk[8];
#pragma unroll
          for (int j = 0; j < 8; ++j) pk[j] = (unsigned)VR[(16 * tq + 2 * j) * 128 + k] | ((unsigned)VR[(16 * tq + 2 * j + 1) * 128 + k] << 16);
          *(LAS u32x4*)(VT + k * TT + 16 * tq) = (u32x4){pk[0], pk[1], pk[2], pk[3]}; *(LAS u32x4*)(VT + k * TT + 16 * tq + 8) = (u32x4){pk[4], pk[5], pk[6], pk[7]}; }
        LBAR();
        { float off = 0.f;
#pragma unroll
          for (int q = 0; q < 4; ++q) { const float s = seg[q * 128 + k]; if (q < tq) off += s; }
#pragma unroll
          for (int j = 0; j < 16; ++j) { const float bt = off + cs[j]; const int t = 16 * tq + j, sw = t * 128 + ((((k >> 3) ^ (t & 15)) << 3) | (k & 7));
              QR[sw] = f2bf(rq[j] * __expf(bt)); ZR[sw] = f2bf(kk[j] * __expf(-bt)); } }
        float gv[4][4];
#pragma unroll
        for (int i = 0; i < 4; ++i)
#pragma unroll
            for (int nb = 0; nb < 4; ++nb) gv[i][nb] = bf2f(GR[(16 * tb + 4 * fq + i) * 128 + 16 * (4 * vh + nb) + fr]);
        LBAR();
        if (item + F.G < 2048) HGO_ISSUE_G(item + F.G);
        bf16x8 aq[4];
#pragma unroll
        for (int ks = 0; ks < 4; ++ks) aq[ks] = *(const LAS bf16x8*)(QR + (16 * tb + fr) * 128 + (((4 * ks + fq) ^ fr) << 3));
#pragma unroll
        for (int sb = 0; sb < 4; ++sb) {
            f32x4 acc = (f32x4){0.f, 0.f, 0.f, 0.f};
            if (sb <= tb) {
#pragma unroll
                for (int ks = 0; ks < 4; ++ks) acc = __builtin_amdgcn_mfma_f32_16x16x32_bf16(aq[ks], *(const LAS bf16x8*)(ZR + (16 * sb + fr) * 128 + (((4 * ks + fq) ^ fr) << 3)), acc, 0, 0, 0);
            }
#pragma unroll
            for (int i = 0; i < 4; ++i) { const int tl = 16 * tb + 4 * fq + i, s = 16 * sb + fr; ATT[(4 * fq + i) * TT + s] = f2bf((s <= tl) ? acc[i] : 0.f); }
        }
        f32x4 o[4];
#pragma unroll
        for (int nb = 0; nb < 4; ++nb) { o[nb] = (f32x4){0.f, 0.f, 0.f, 0.f};
#pragma unroll
            for (int ks = 0; ks < 4; ++ks) o[nb] = __builtin_amdgcn_mfma_f32_16x16x32_bf16(aq[ks], stf[nb][ks], o[nb], 0, 0, 0); }
        asm volatile("s_waitcnt lgkmcnt(0)" ::: "memory");
        bf16x8 aa[2];
#pragma unroll
        for (int ks = 0; ks < 2; ++ks) aa[ks] = lds_frag(ATT, fr, TT, 32 * ks + 8 * fq);
#pragma unroll
        for (int nb = 0; nb < 4; ++nb) { const int vrow = 16 * (4 * vh + nb) + fr;
#pragma unroll
            for (int ks = 0; ks < 2; ++ks) o[nb] = __builtin_amdgcn_mfma_f32_16x16x32_bf16(aa[ks], lds_frag(VT, vrow, TT, 32 * ks + 8 * fq), o[nb], 0, 0, 0); }
        float sq[4];
#pragma unroll
        for (int i = 0; i < 4; ++i) { float s = 0.f;
#pragma unroll
            for (int nb = 0; nb < 4; ++nb) s += o[nb][i] * o[nb][i];
            s += __shfl_xor(s, 1); s += __shfl_xor(s, 2); s += __shfl_xor(s, 4); s += __shfl_xor(s, 8); sq[i] = s; }
        if (fr == 0) {
#pragma unroll
            for (int i = 0; i < 4; ++i) ssqp[vh * 64 + 16 * tb + 4 * fq + i] = sq[i]; }
        LBAR();
        const float nwv[4] = {nw0, nw1, nw2, nw3};
#pragma unroll
        for (int i = 0; i < 4; ++i) { const int tl = 16 * tb + 4 * fq + i; const float r = 1.0f / sqrtf((ssqp[tl] + ssqp[64 + tl]) * (1.0f / 128.0f) + EPS);
#pragma unroll
            for (int nb = 0; nb < 4; ++nb) { const int v = 16 * (4 * vh + nb) + fr; const float g = gv[i][nb];
                VR[tl * 128 + v] = f2bf(o[nb][i] * r * nwv[nb] * (g * sigmoidf_(g))); } }
        LBAR();
        u32x4 ov[2];
#pragma unroll
        for (int q = 0; q < 2; ++q) { const int cix = tid + 512 * q; ov[q] = *(const LAS u32x4*)(VR + (cix >> 4) * 128 + (cix & 15) * 8); }
        asm volatile("s_waitcnt vmcnt(0)" ::: "memory");
        bf16_t* mix = (bf16_t*)(ws + WS_MIX) + t0 * DM + h * 128;
#pragma unroll
        for (int q = 0; q < 2; ++q) { const int cix = tid + 512 * q; *(u32x4*)(mix + (size_t)(cix >> 4) * DM + (cix & 15) * 8) = ov[q]; }
    }
#undef HGO_ISSUE_QZV
#undef HGO_ISSUE_G
}

__device__ __forceinline__ void ml_out_phase(const Params& p, Frame& F) {
    unsigned char* ws = p.ws; const int tid = F.tid, lane = F.lane, w = F.wave;
    LAS bf16_t* QR = (LAS bf16_t*)(F.lds); LAS bf16_t* KR = (LAS bf16_t*)(F.lds + 17408); LAS bf16_t* VR = (LAS bf16_t*)(F.lds + 34816); LAS bf16_t* VT = (LAS bf16_t*)(F.lds + 67584);
    LAS bf16_t* ATT = (LAS bf16_t*)(F.lds + 104448) + w * (16 * TT);
    LAS float* avec = (LAS float*)(F.lds + 122880); LAS float* Mvec = avec + 64; LAS float* wint = avec + 128; LAS float* eneg = avec + 192; LAS float* ssqp = avec + 256; LAS float* qnl = avec + 384;
    float nli = 0.f, nlf = 0.f, nmst = 0.f;
#define MLO_ISSUE_QK(it_) do { const int sh_ = (it_) >> 7, c_ = (it_) & 127, b_ = sh_ >> 2, h_ = sh_ & 3; const size_t t0_ = (size_t)b_ * SEQ + (size_t)c_ * 64; const bf16_t* pj_ = (const bf16_t*)(ws + WS_PROJ) + t0_ * NPROJ; \
        dma_rows<16>((LAS unsigned char*)QR, pj_ + C_MQ + h_ * 128 - 3 * (size_t)NPROJ, NPROJ, 17, w, lane); dma_rows<16>((LAS unsigned char*)KR, pj_ + C_MK + h_ * 128 - 3 * (size_t)NPROJ, NPROJ, 17, w, lane); \
        const float* gt_ = (const float*)(ws + WS_GATES) + (t0_ + lane) * 8; nli = gt_[h_]; nlf = gt_[4 + h_]; nmst = ((const float*)(ws + WS_MST))[(it_)]; \
        { const int cq_ = h_ * 128 + (tid & 127), ck_ = 512 + cq_; _Pragma("unroll") for (int j_ = 0; j_ < 4; ++j_) { ncw[j_] = p.in[5][1024 * j_ + cq_]; ncw[5 + j_] = p.in[5][1024 * j_ + ck_]; } ncw[4] = p.in[6][cq_]; ncw[9] = p.in[6][ck_]; } \
        nnw = p.in[9][h_ * 256 + (tid & 255)]; } while (0)
#define MLO_ISSUE_V(it_, col_) do { const int sh_ = (it_) >> 7, c_ = (it_) & 127, b_ = sh_ >> 2, h_ = sh_ & 3; const bf16_t* pj_ = (const bf16_t*)(ws + WS_PROJ) + ((size_t)b_ * SEQ + (size_t)c_ * 64) * NPROJ; \
        dma_rows<32>((LAS unsigned char*)VR, pj_ + (col_) + h_ * 256, NPROJ, 32, w, lane); } while (0)
    const int fr = lane & 15, fq = lane >> 4, tb = w & 3, vh = w >> 2;
    float ncw[10], nnw = 0.f;
    LAS float* nwl = avec + 512;
#pragma unroll
    for (int j = 0; j < 10; ++j) ncw[j] = 0.f;
    LBAR();
    int item = F.vcu;
    if (item < 1024) { MLO_ISSUE_QK(item); MLO_ISSUE_V(item, C_MV); }
    for (; item < 1024; item += F.G) {
        const int sh = item >> 7, c = item & 127, b = sh >> 2, h = sh & 3; const size_t t0 = (size_t)b * SEQ + (size_t)c * 64;
        const float li = nli, lf = nlf, mst = nmst;
        float cwv[10];
#pragma unroll
        for (int j = 0; j < 10; ++j) cwv[j] = ncw[j];
        const float nwx = nnw;
        VLBAR();
        if (tid < 256) nwl[tid] = nwx;
        f32x4 nsv[8]; bf16x8 ctf[4][4], ctg[4][4];
        { const bf16_t* CT = (const bf16_t*)(ws + WS_CST) + (size_t)item * 32768;
#pragma unroll
          for (int nb = 0; nb < 4; ++nb)
#pragma unroll
              for (int ks = 0; ks < 4; ++ks) ctf[nb][ks] = *(const bf16x8*)(CT + (size_t)(16 * (8 * vh + nb) + fr) * 128 + 32 * ks + 8 * fq); }
        __builtin_amdgcn_sched_barrier(0);
        if (w == 0) {
            float g = lf;
#pragma unroll
            for (int o = 1; o < 64; o <<= 1) { const float v = __shfl_up(g, o); if (lane >= o) g += v; }
            const float a = li - g; float pm = a;
#pragma unroll
            for (int o = 1; o < 64; o <<= 1) { const float v = __shfl_up(pm, o); if (lane >= o) pm = fmaxf(pm, v); }
            const float M = fmaxf(mst, pm);
            int ln = lane; asm volatile("" : "+v"(ln)); LAS float* gs = avec + ln;
            gs[0] = a; gs[64] = M; gs[128] = __expf(mst - M); gs[192] = __expf(-(g + M));
        }
        { const int v = tid & 255, hf = tid >> 8; unsigned pk[16];
#pragma unroll
          for (int j = 0; j < 16; ++j) pk[j] = (unsigned)VR[(32 * hf + 2 * j) * 256 + v] | ((unsigned)VR[(32 * hf + 2 * j + 1) * 256 + v] << 16);
#pragma unroll
          for (int q = 0; q < 4; ++q) *(LAS u32x4*)(VT + v * TT + 32 * hf + 8 * q) = (u32x4){pk[4 * q], pk[4 * q + 1], pk[4 * q + 2], pk[4 * q + 3]}; }
        const int d = tid & 127, tq = w >> 1;
        float rq[19], rk[19];
#pragma unroll
        for (int j = 0; j < 19; ++j) { const bool z = (c == 0 && 16 * tq + j < 3); const float a = bf2f(QR[(16 * tq + j) * 128 + d]), bb = bf2f(KR[(16 * tq + j) * 128 + d]); rq[j] = z ? 0.f : a; rk[j] = z ? 0.f : bb; }
        LBAR();
        MLO_ISSUE_V(item, C_MO);
        { const float q0 = cwv[0], q1 = cwv[1], q2 = cwv[2], q3 = cwv[3], qb = cwv[4], k0 = cwv[5], k1 = cwv[6], k2 = cwv[7], k3 = cwv[8], kb = cwv[9];
#pragma unroll
          for (int j = 0; j < 16; ++j) { const float a = qb + q0 * rq[j] + q1 * rq[j + 1] + q2 * rq[j + 2] + q3 * rq[j + 3]; const float bq = kb + k0 * rk[j] + k1 * rk[j + 1] + k2 * rk[j + 2] + k3 * rk[j + 3];
              const int t = 16 * tq + j, sw = t * 128 + ((((d >> 3) ^ (t & 15)) << 3) | (d & 7));
              QR[sw] = f2bf(a * sigmoidf_(a) * 0.08838834764831845f); KR[sw] = f2bf(bq * sigmoidf_(bq)); } }
        LBAR();
        { const float* nst = (const float*)(ws + WS_NST) + (size_t)item * 128;
#pragma unroll
          for (int ks = 0; ks < 4; ++ks) { nsv[2 * ks] = *(const f32x4*)(nst + 32 * ks + 8 * fq); nsv[2 * ks + 1] = *(const f32x4*)(nst + 32 * ks + 8 * fq + 4); } }
        __builtin_amdgcn_sched_barrier(0);
        bf16x8 aq[4];
#pragma unroll
        for (int ks = 0; ks < 4; ++ks) aq[ks] = *(const LAS bf16x8*)(QR + (16 * tb + fr) * 128 + (((4 * ks + fq) ^ fr) << 3));
        float Mr[4], wi[4], rsum[4];
#pragma unroll
        for (int i = 0; i < 4; ++i) { const int tl = 16 * tb + 4 * fq + i; Mr[i] = Mvec[tl]; wi[i] = wint[tl]; rsum[i] = 0.f; }
#pragma unroll
        for (int sb = 0; sb < 4; ++sb) {
            f32x4 acc = (f32x4){0.f, 0.f, 0.f, 0.f};
            if (sb <= tb) {
#pragma unroll
                for (int ks = 0; ks < 4; ++ks) acc = __builtin_amdgcn_mfma_f32_16x16x32_bf16(aq[ks], *(const LAS bf16x8*)(KR + (16 * sb + fr) * 128 + (((4 * ks + fq) ^ fr) << 3)), acc, 0, 0, 0);
            }
            const int s = 16 * sb + fr; const float as = avec[s];
#pragma unroll
            for (int i = 0; i < 4; ++i) { const int tl = 16 * tb + 4 * fq + i; const float v = (s <= tl) ? acc[i] * __expf(as - Mr[i]) : 0.f; rsum[i] += v; ATT[(4 * fq + i) * TT + s] = f2bf(v); }
        }
#pragma unroll
        for (int i = 0; i < 4; ++i) { float s = rsum[i]; s += __shfl_xor(s, 1); s += __shfl_xor(s, 2); s += __shfl_xor(s, 4); s += __shfl_xor(s, 8); rsum[i] = s; }
        f32x4 o[8];
#pragma unroll
        for (int nb = 0; nb < 4; ++nb) { o[nb] = (f32x4){0.f, 0.f, 0.f, 0.f};
#pragma unroll
            for (int ks = 0; ks < 4; ++ks) o[nb] = __builtin_amdgcn_mfma_f32_16x16x32_bf16(aq[ks], ctf[nb][ks], o[nb], 0, 0, 0);
#pragma unroll
            for (int i = 0; i < 4; ++i) o[nb][i] *= wi[i]; }
        { float s = 0.f;
#pragma unroll
          for (int ks = 0; ks < 4; ++ks) { const f32x4 n0 = nsv[2 * ks], n1 = nsv[2 * ks + 1];
              const unsigned* aw = (const unsigned*)&aq[ks];
              s += bflo(aw[0]) * n0[0] + bfhi(aw[0]) * n0[1] + bflo(aw[1]) * n0[2] + bfhi(aw[1]) * n0[3] + bflo(aw[2]) * n1[0] + bfhi(aw[2]) * n1[1] + bflo(aw[3]) * n1[2] + bfhi(aw[3]) * n1[3]; }
          s += __shfl_xor(s, 16); s += __shfl_xor(s, 32);
          if (fq == 0) qnl[w * 16 + fr] = s; }
        __builtin_amdgcn_sched_barrier(0);
        { const bf16_t* CT = (const bf16_t*)(ws + WS_CST) + (size_t)item * 32768;
#pragma unroll
          for (int nb = 0; nb < 4; ++nb)
#pragma unroll
              for (int ks = 0; ks < 4; ++ks) ctg[nb][ks] = *(const bf16x8*)(CT + (size_t)(16 * (8 * vh + 4 + nb) + fr) * 128 + 32 * ks + 8 * fq); }
        __builtin_amdgcn_sched_barrier(0);
        asm volatile("s_waitcnt lgkmcnt(0)" ::: "memory");
        bf16x8 aa[2];
#pragma unroll
        for (int ks = 0; ks < 2; ++ks) aa[ks] = lds_frag(ATT, fr, TT, 32 * ks + 8 * fq);
#pragma unroll
        for (int nb = 0; nb < 4; ++nb) { const int vrow = 16 * (8 * vh + nb) + fr;
#pragma unroll
            for (int ks = 0; ks < 2; ++ks) o[nb] = __builtin_amdgcn_mfma_f32_16x16x32_bf16(aa[ks], lds_frag(VT, vrow, TT, 32 * ks + 8 * fq), o[nb], 0, 0, 0); }
        __builtin_amdgcn_sched_barrier(0);
#pragma unroll
        for (int nb = 4; nb < 8; ++nb) { o[nb] = (f32x4){0.f, 0.f, 0.f, 0.f};
#pragma unroll
            for (int ks = 0; ks < 4; ++ks) o[nb] = __builtin_amdgcn_mfma_f32_16x16x32_bf16(aq[ks], ctg[nb - 4][ks], o[nb], 0, 0, 0);
#pragma unroll
            for (int i = 0; i < 4; ++i) o[nb][i] *= wi[i];
            const int vrow = 16 * (8 * vh + nb) + fr;
#pragma unroll
            for (int ks = 0; ks < 2; ++ks) o[nb] = __builtin_amdgcn_mfma_f32_16x16x32_bf16(aa[ks], lds_frag(VT, vrow, TT, 32 * ks + 8 * fq), o[nb], 0, 0, 0); }
        float sq[4];
#pragma unroll
        for (int i = 0; i < 4; ++i) { const int tl = 16 * tb + 4 * fq + i; const float den = wi[i] * qnl[w * 16 + 4 * fq + i] + rsum[i]; const float inv = 1.0f / fmaxf(fabsf(den), eneg[tl]);
            float s = 0.f;
#pragma unroll
            for (int nb = 0; nb < 8; ++nb) { o[nb][i] *= inv; s += o[nb][i] * o[nb][i]; }
            s += __shfl_xor(s, 1); s += __shfl_xor(s, 2); s += __shfl_xor(s, 4); s += __shfl_xor(s, 8); sq[i] = s; }
        if (fr == 0) {
#pragma unroll
            for (int i = 0; i < 4; ++i) ssqp[vh * 64 + 16 * tb + 4 * fq + i] = sq[i]; }
        VLBAR();
        if (item + F.G < 1024) MLO_ISSUE_QK(item + F.G);
#pragma unroll
        for (int i = 0; i < 4; ++i) { const int tl = 16 * tb + 4 * fq + i; const float r = 1.0f / sqrtf((ssqp[tl] + ssqp[64 + tl]) * (1.0f / 256.0f) + EPS);
#pragma unroll
            for (int nb = 0; nb < 8; ++nb) { const int v = 16 * (8 * vh + nb) + fr; const float g = bf2f(VR[tl * 256 + v]);
                VR[tl * 256 + v] = f2bf(o[nb][i] * r * nwl[v] * sigmoidf_(g)); } }
        LBAR();
        bf16_t* mix = (bf16_t*)(ws + WS_MIX) + t0 * DM + 1024 + h * 256;
        for (int cix = tid; cix < 2048; cix += 512) { const int r = cix >> 5, cc = cix & 31; *(u32x4*)(mix + (size_t)r * DM + cc * 8) = *(const LAS u32x4*)(VR + r * 256 + cc * 8); }
        LBAR();
        if (item + F.G < 1024) MLO_ISSUE_V(item + F.G, C_MV);
    }
#undef MLO_ISSUE_QK
#undef MLO_ISSUE_V
}

__device__ __forceinline__ void p4_router(const Params& p, Frame& F) {
    unsigned char* ws = p.ws;
    LAS float* part = (LAS float*)(F.lds);
    LAS float* ssqp = (LAS float*)(F.lds + 32768);
    LAS int* hist = (LAS int*)(F.lds + L_HIST); LAS int* gbase = hist + 32;
    const float* x1 = (const float*)(ws + WS_X1);
    unsigned* gcnt = (unsigned*)(ws + WS_CTL) + CW_CNT;
    for (int blk = F.vcu; blk < T_TOK / 64; blk += F.G) {
        const int g = F.wave >> 2, ks = F.wave & 3, r0 = blk * 64 + g * 32;
        f32x16 acc;
#pragma unroll
        for (int i = 0; i < 16; ++i) acc[i] = 0.f;
        float ssq;
        skinny_f32<1>(x1, r0, ks * 512, p.in[12], p.in[11], nullptr, acc, ssq, F.lane);
        const int n = F.lane & 31, hh = F.lane >> 5;
#pragma unroll
        for (int i = 0; i < 16; ++i) { const int row = (i & 3) + 8 * (i >> 2) + 4 * hh; part[((g * 4 + ks) * 32 + row) * 32 + n] = acc[i]; }
        if (F.lane < 32) ssqp[(g * 4 + ks) * 32 + F.lane] = ssq;
        if (F.tid < 32) hist[F.tid] = 0;
        __syncthreads();
        int es[4] = {0, 0, 0, 0}, lp[4] = {0, 0, 0, 0}; float gv[4] = {0.f, 0.f, 0.f, 0.f}; float rs = 0.f; const int t = blk * 64 + F.tid;
        if (F.tid < 64) {
            const int gg = F.tid >> 5, mm = F.tid & 31;
            float s = 0.f;
#pragma unroll
            for (int q = 0; q < 4; ++q) s += ssqp[(gg * 4 + q) * 32 + mm];
            rs = 1.0f / sqrtf(s * (1.0f / DM) + EPS);
            float lg[32];
#pragma unroll
            for (int e = 0; e < 32; ++e) { float v = 0.f;
#pragma unroll
                for (int q = 0; q < 4; ++q) v += part[((gg * 4 + q) * 32 + mm) * 32 + e];
                lg[e] = v * rs + p.in[13][e]; }
            unsigned used = 0u; float tv[4];
#pragma unroll
            for (int j = 0; j < 4; ++j) { float best = -3.0e38f; int bi = 0;
#pragma unroll
                for (int e = 0; e < 32; ++e) { const bool ok = !((used >> e) & 1u) && (lg[e] > best); best = ok ? lg[e] : best; bi = ok ? e : bi; }
                used |= 1u << bi; es[j] = bi; tv[j] = best; }
            float den = 0.f;
#pragma unroll
            for (int j = 0; j < 4; ++j) { gv[j] = __expf(tv[j] - tv[0]); den += gv[j]; }
            const float inv = 1.0f / den;
#pragma unroll
            for (int j = 0; j < 4; ++j) { gv[j] *= inv; lp[j] = __hip_atomic_fetch_add(&hist[es[j]], 1, __ATOMIC_RELAXED, __HIP_MEMORY_SCOPE_WORKGROUP); }
        }
        __syncthreads();
        if (F.tid < 32) { const int cnt = hist[F.tid]; gbase[F.tid] = cnt ? (int)atomicAdd(&gcnt[F.tid], (unsigned)cnt) : 0; }
        __syncthreads();
        if (F.tid < 64) {
            ((float*)(ws + WS_RSTD2))[t] = rs;
#pragma unroll
            for (int j = 0; j < 4; ++j) { const int e = es[j], pos = gbase[e] + lp[j];
                ((int*)(ws + WS_LTOK))[e * LIST_STRIDE + pos] = t; ((float*)(ws + WS_LRS))[e * LIST_STRIDE + pos] = rs;
                ((int*)(ws + WS_TOKE))[t * 4 + j] = e; ((int*)(ws + WS_TOKP))[t * 4 + j] = pos; ((float*)(ws + WS_TOKG))[t * 4 + j] = gv[j]; }
        }
        __syncthreads();
    }
}
__device__ __forceinline__ void moe_tables(const Params& p, Frame& F) {
    LAS int* tile0 = (LAS int*)(F.lds + L_TILE0); LAS int* cnt = (LAS int*)(F.lds + L_CNT);
    if (F.tid < 64) {
        const unsigned* gcnt = (const unsigned*)(p.ws + WS_CTL) + CW_CNT; const int e = F.tid & 31;
        const int c = (int)__hip_atomic_load(gcnt + e, __ATOMIC_RELAXED, __HIP_MEMORY_SCOPE_AGENT); const int nt = (c + 255) >> 8;
        int inc = nt;
#pragma unroll
        for (int o = 1; o < 32; o <<= 1) { const int v = __shfl_up(inc, o, 32); if (e >= o) inc += v; }
        if (F.tid < 32) { cnt[e] = c; tile0[e] = inc - nt; if (e == NEXP - 1) tile0[NEXP] = inc; }
    }
    __syncthreads();
}

__device__ __forceinline__ void p7_final(const Params& p, Frame& F) {
    unsigned char* ws = p.ws; const LAS int* tile0 = (const LAS int*)(F.lds + L_TILE0);
    const float* x1 = (const float*)(ws + WS_X1); const unsigned char* ys = (const unsigned char*)(ws + WS_YS); const float* fw = p.in[20];
    const int gw = F.vcu * 8 + F.wave, NGW = F.G * 8, lane = F.lane;
    LAS float* fwl = (LAS float*)(F.lds + 16384);
    for (int i = F.tid; i < DM; i += 512) fwl[i] = fw[i];
    __syncthreads();
    if (gw >= T_TOK) return;
    f32x4 v[8], nv[8]; i32x4 me, mp, nme, nmp; f32x4 mg, nmg;
#define P7_LOAD(V_, E_, P_, G_, t_) do { E_ = *(const i32x4*)((const int*)(ws + WS_TOKE) + (t_) * 4); P_ = *(const i32x4*)((const int*)(ws + WS_TOKP) + (t_) * 4); G_ = *(const f32x4*)((const float*)(ws + WS_TOKG) + (t_) * 4); \
        _Pragma("unroll") for (int i_ = 0; i_ < 4; ++i_) { V_[2 * i_] = *(const f32x4*)(x1 + (size_t)(t_) * DM + 512 * i_ + 8 * lane); V_[2 * i_ + 1] = *(const f32x4*)(x1 + (size_t)(t_) * DM + 512 * i_ + 8 * lane + 4); } } while (0)
    P7_LOAD(v, me, mp, mg, gw);
    for (int t = gw; t < T_TOK; t += NGW) {
        u32x2 y[4][4];
#pragma unroll
        for (int j = 0; j < 4; ++j) { const size_t slot = (size_t)tile0[me[j]] * 256 + mp[j];
#pragma unroll
            for (int i = 0; i < 4; ++i) y[j][i] = *(const u32x2*)(ys + slot * DM + 512 * i + 8 * lane); }
        const int tn = (t + NGW < T_TOK) ? t + NGW : t;
        P7_LOAD(nv, nme, nmp, nmg, tn);
#pragma unroll
        for (int j = 0; j < 4; ++j) { const float g = mg[j]; __builtin_amdgcn_sched_barrier(0);
#pragma unroll
            for (int i = 0; i < 4; ++i) {
                const f32x2_t a0 = __builtin_amdgcn_cvt_pk_f32_fp8(y[j][i].x, false), a1 = __builtin_amdgcn_cvt_pk_f32_fp8(y[j][i].x, true), a2 = __builtin_amdgcn_cvt_pk_f32_fp8(y[j][i].y, false), a3 = __builtin_amdgcn_cvt_pk_f32_fp8(y[j][i].y, true);
                v[2 * i][0] += g * a0.x; v[2 * i][1] += g * a0.y; v[2 * i][2] += g * a1.x; v[2 * i][3] += g * a1.y;
                v[2 * i + 1][0] += g * a2.x; v[2 * i + 1][1] += g * a2.y; v[2 * i + 1][2] += g * a3.x; v[2 * i + 1][3] += g * a3.y; } }
        float s = 0.f;
#pragma unroll
        for (int i = 0; i < 8; ++i) s += (v[i][0] * v[i][0] + v[i][1] * v[i][1]) + (v[i][2] * v[i][2] + v[i][3] * v[i][3]);
        const float rs = 1.0f / sqrtf(wave_sum(s) * (1.0f / DM) + EPS);
        int fo = 8 * lane; asm volatile("" : "+v"(fo));
#pragma unroll
        for (int i = 0; i < 4; ++i) {
            const f32x4 w0 = *(const LAS f32x4*)(fwl + 512 * i + fo), w1 = *(const LAS f32x4*)(fwl + 512 * i + fo + 4);
            *(f32x4*)(p.out + (size_t)t * DM + 512 * i + 8 * lane) = v[2 * i] * rs * w0; *(f32x4*)(p.out + (size_t)t * DM + 512 * i + 8 * lane + 4) = v[2 * i + 1] * rs * w1; }
#pragma unroll
        for (int i = 0; i < 8; ++i) v[i] = nv[i];
        me = nme; mp = nmp; mg = nmg;
    }
#undef P7_LOAD
}

#ifndef NG_GEMM
#define NG_GEMM 180
#endif
#ifndef NG_MOE1
#define NG_MOE1 232
#endif
constexpr int CONV_N_GU = NEXP * 2 * (DM / 128) * (DFF / 64), CONV_N_ALL = NEXP * 3 * (DM / 128) * (DFF / 64);
constexpr int N_PHASES = 10;
__global__ void __launch_bounds__(512, 2) hymba_fwd(Params p) {
    extern __shared__ __attribute__((aligned(16))) unsigned char lds_raw[];
    Frame F; F.lds = (LAS unsigned char*)lds_raw; F.tid = threadIdx.x; F.lane = F.tid & 63; F.wave = __builtin_amdgcn_readfirstlane(F.tid >> 6);
    F.G = gridDim.x; { const int bx = blockIdx.x; F.vcu = (F.G % 8 == 0) ? (bx % 8) * (F.G / 8) + bx / 8 : bx; }
    for (int u = F.tid; u < (LDS_BYTES - LDSCTL_OFF) / 4; u += 512) ((LAS unsigned*)(F.lds + LDSCTL_OFF))[u] = 0u;
    __syncthreads();
    unsigned char* ws = p.ws;
    unsigned* ctl = (unsigned*)(ws + WS_CTL);
    XcdBarrier bar; bar.bar = ctl + CW_BAR + p.li * XCD_BAR_WORDS; bar.x = 0; bar.st = nullptr;
    const int lo = p.ph_lo, hi = p.ph_hi;
    if (hi - lo > 1) bar = xcd_barrier_post(ctl + CW_BAR + p.li * XCD_BAR_WORDS, (volatile LAS unsigned*)(F.lds + L_MISC) + 8);
#define IN(k) (lo <= (k) && (k) < hi)
#define SEAM(k) do { if (IN(k) && IN((k) + 1)) xcd_barrier(bar); } while (0)
    LAS unsigned char* ring = F.lds;

    if (IN(0)) { p0_prologue(p, F); }
    SEAM(0);
    if (IN(1)) {
        const int ng = (F.G == 256) ? NG_GEMM : F.G;
        if ((int)blockIdx.x < ng) {
            pg8::Gemm g{(const bf16_t*)(ws + WS_XB), (const bf16_t*)(ws + WS_WIN), DM}; pg8::StaticOrder S; S.init(T_TOK, NPROJ, ng, (int)blockIdx.x);
            EpiProj E{(bf16_t*)(ws + WS_PROJ), (const float*)(ws + WS_RSTD1)};
            pg8::gemm_phase<EpiProj, pg8::StaticOrder, false, false, true, false>(ring, g, S, E);
            if (ng == F.G) { wout_transpose(p, F, (int)blockIdx.x * 8 + F.wave, F.G * 8); moe_weight_convert(p, F, (int)blockIdx.x * 8 + F.wave, F.G * 8, 0, CONV_N_GU); }
        } else { wout_transpose(p, F, ((int)blockIdx.x - ng) * 8 + F.wave, (F.G - ng) * 8); moe_weight_convert(p, F, ((int)blockIdx.x - ng) * 8 + F.wave, (F.G - ng) * 8, 0, CONV_N_GU); }
    }
    SEAM(1);
    if (IN(2)) {
        hg_local_phase(p, F); ml_local_phase(p, F);
    }
    SEAM(2);
    if (IN(3)) { p2_scan(p, F); }
    SEAM(3);
    if (IN(4)) {
        hg_out_phase(p, F); ml_out_phase(p, F);
    }
    SEAM(4);
    if (IN(5)) {
        pg8::Gemm g{(const bf16_t*)(ws + WS_MIX), (const bf16_t*)(ws + WS_WOUT), DM}; pg8::StaticOrder S; S.init(T_TOK, DM, F.G, (int)blockIdx.x);
        EpiOut E{p.in[0], (float*)(ws + WS_X1), (unsigned char*)(ws + WS_X1B)};
        pg8::gemm_phase<EpiOut, pg8::StaticOrder, false, false, true, false>(ring, g, S, E);
    }
    SEAM(5);
    if (IN(6)) { p4_router(p, F); }
    SEAM(6);
    if (IN(7)) {
        const int ngm = (F.G == 256) ? NG_MOE1 : F.G;
        if (ngm == F.G) { moe_weight_convert(p, F, (int)blockIdx.x * 8 + F.wave, F.G * 8, CONV_N_GU, CONV_N_ALL); __syncthreads(); }
        if ((int)blockIdx.x < ngm) {
        moe_tables(p, F);
        pg8::Gemm g{(const bf16_t*)(ws + WS_X1B), (const bf16_t*)(ws + WS_WGU), DM / 2};
        pg8::MoeOrder S; S.init((const LAS int*)(F.lds + L_TILE0), (const LAS int*)(F.lds + L_CNT), (const int*)(ws + WS_LTOK), 16, ngm, (int)blockIdx.x);
        EpiMoe1 E{(unsigned char*)(ws + WS_ACT), p.in[15], p.in[17], (const float*)(ws + WS_LRS), (const LAS int*)(F.lds + L_CNT)};
        pg8::gemm_phase<EpiMoe1, pg8::MoeOrder, true, true, false, true>(ring, g, S, E);
        } else moe_weight_convert(p, F, ((int)blockIdx.x - ngm) * 8 + F.wave, (F.G - ngm) * 8, CONV_N_GU, CONV_N_ALL);
    }
    SEAM(7);
    if (IN(8)) {
        moe_tables(p, F);
        pg8::Gemm g{(const bf16_t*)(ws + WS_ACT), (const bf16_t*)(ws + WS_WDN), DFF / 2};
        pg8::MoeOrder S; S.init((const LAS int*)(F.lds + L_TILE0), (const LAS int*)(F.lds + L_CNT), (const int*)(ws + WS_LTOK), 8, F.G, (int)blockIdx.x);
        EpiMoe2 E{(unsigned char*)(ws + WS_YS), p.in[19]};
        pg8::gemm_phase<EpiMoe2, pg8::MoeOrder, false, true, true, true>(ring, g, S, E);
    }
    SEAM(8);
    if (IN(9)) { moe_tables(p, F); p7_final(p, F); }
#undef IN
#undef SEAM
}

extern "C" void kernel_launch(void* const* d_in, const int* in_sizes, int n_in, void* d_out, int out_size, void* d_ws, size_t ws_size, hipStream_t stream) {
    static int grid = 0;
    if (grid == 0) {
        if (n_in != 21 || in_sizes[0] != T_TOK * DM || out_size != T_TOK * DM || ws_size < WS_END) { fprintf(stderr, "kernel_launch: unexpected shapes / workspace (n_in %d, ws %zu < %zu)\n", n_in, ws_size, (size_t)WS_END); grid = -1; return; }
        int dev = 0, cus = 0, per_cu = 0;
        if (hipGetDevice(&dev) != hipSuccess || hipDeviceGetAttribute(&cus, hipDeviceAttributeMultiprocessorCount, dev) != hipSuccess) { grid = -1; return; }
        if (hipFuncSetAttribute((const void*)hymba_fwd, hipFuncAttributeMaxDynamicSharedMemorySize, LDS_BYTES) != hipSuccess) { fprintf(stderr, "kernel_launch: hipFuncSetAttribute failed\n"); grid = -1; return; }
        if (hipOccupancyMaxActiveBlocksPerMultiprocessor(&per_cu, (const void*)hymba_fwd, 512, LDS_BYTES) != hipSuccess || per_cu < 1) { fprintf(stderr, "kernel_launch: occupancy query says %d\n", per_cu); }
        (void)hipGetLastError();
        grid = cus;
    }
    if (grid < 0) return;
    (void)hipMemsetAsync((char*)d_ws + WS_CTL, 0, CTL_ZERO_BYTES, stream);
    Params p{};
    for (int i = 0; i < 21; ++i) p.in[i] = (const float*)d_in[i];
    p.out = (float*)d_out; p.ws = (unsigned char*)d_ws; p.pad = 0;
#if MK_N_LAUNCHES == 1
    p.ph_lo = 0; p.ph_hi = N_PHASES; p.li = 0;
    hipLaunchKernelGGL(hymba_fwd, dim3(grid), dim3(512), LDS_BYTES, stream, p);
#else
    for (int k = 0; k < N_PHASES; ++k) { p.ph_lo = k; p.ph_hi = k + 1; p.li = 0; hipLaunchKernelGGL(hymba_fwd, dim3(grid), dim3(512), LDS_BYTES, stream, p); }
#endif
}
```

```cpp
#include <hip/hip_runtime.h>
#include <cstdio>
#include <cstdint>

#ifndef MK_N_LAUNCHES
#define MK_N_LAUNCHES 1
#endif

constexpr int T_TOK = 16384, SEQ = 8192, DM = 2048, D_IN = 7176, NPROJ = 7168;
constexpr int NCHUNK = 128;
constexpr int NEXP = 32, TOPK = 4, DFF = 2048;
constexpr int LIST_STRIDE = 16384;
constexpr int MAX_TILES = 288;
constexpr float EPS = 1e-6f;
constexpr int C_HQ = 0, C_HF = 1024, C_HI = 2048, C_HG = 3072, C_MQ = 4096, C_MK = 4608, C_MV = 5120, C_MO = 6144;

#define GAS __attribute__((address_space(1)))
#define LAS __attribute__((address_space(3)))
typedef unsigned short bf16_t;
typedef short bf16x8 __attribute__((ext_vector_type(8)));
typedef float f32x4 __attribute__((ext_vector_type(4)));
typedef float f32x16 __attribute__((ext_vector_type(16)));
typedef unsigned u32x4 __attribute__((ext_vector_type(4)));
typedef unsigned u32x2 __attribute__((ext_vector_type(2)));
typedef int i32x4 __attribute__((ext_vector_type(4)));
typedef int i32x8 __attribute__((ext_vector_type(8)));

typedef float f32x2_t __attribute__((ext_vector_type(2)));
typedef __bf16 bf16x2_t __attribute__((ext_vector_type(2)));
__device__ __forceinline__ unsigned cvt_pk_bf16(float lo, float hi) { const f32x2_t v = {lo, hi}; return __builtin_bit_cast(unsigned, __builtin_convertvector(v, bf16x2_t)); }
__device__ __forceinline__ unsigned cvt4_fp8(float a, float b, float c, float d) { int w = 0; w = __builtin_amdgcn_cvt_pk_fp8_f32(a, b, w, false); w = __builtin_amdgcn_cvt_pk_fp8_f32(c, d, w, true); return (unsigned)w; }
__device__ __forceinline__ float bf2f(bf16_t b) { return __uint_as_float(((unsigned)b) << 16); }
__device__ __forceinline__ float bflo(unsigned w) { return __uint_as_float(w << 16); }
__device__ __forceinline__ float bfhi(unsigned w) { return __uint_as_float(w & 0xffff0000u); }
__device__ __forceinline__ float sigmoidf_(float x) { return __builtin_amdgcn_rcpf(1.0f + __expf(-x)); }
__device__ __forceinline__ float sig1702_(float x) { return __builtin_amdgcn_rcpf(1.0f + __builtin_amdgcn_exp2f(x * -2.4554669f)); }

namespace pg8 {
constexpr int BM = 256, BK = 64, HALF = 128, HTB = HALF * BK * 2, STAGE_BYTES = 8 * HTB, NXCD = 8, WGM = 8;
__host__ __device__ __forceinline__ int lds_byte(int r, int c) { const int st = (r >> 4) * 2 + (c >> 5), rr = r & 15, cc = c & 31, ob = rr * 64 + cc * 2; return st * 1024 + (ob ^ (((ob >> 9) & 1) << 5)); }
__host__ __device__ __forceinline__ void stage_rc(int b, int& R, int& C) { const int st = b / 1024, sb = b % 1024, swz = sb ^ (((sb >> 9) & 1) << 5); R = (st >> 1) * 16 + swz / 64; C = (st & 1) * 32 + (swz % 64) / 2; }
__host__ __device__ __forceinline__ int perm32(int rho) { const int n = rho >> 4, i = rho & 15; return 8 * (i >> 2) + 4 * n + (i & 3); }

struct Unit { int pm, pn, e, r0; };
struct Gemm { const bf16_t* A; const bf16_t* Bt; int K; };

struct StaticOrder {
    int nM, nN, nwg, G, c;
    __device__ void init(int M, int N, int G_, int c_) { nM = M / BM; nN = N / BM; nwg = nM * nN; G = G_; c = c_; }
    __device__ bool next(int i, Unit& u) const {
        const long L = (long)i * G + c; if (L >= nwg) return false;
        int wgid = (int)L; { const int q = nwg / NXCD, r = nwg % NXCD, xcd = wgid % NXCD, off = wgid / NXCD; wgid = (xcd < r ? xcd * (q + 1) : r * (q + 1) + (xcd - r) * q) + off; }
        const int nig = WGM * nN, gid = wgid / nig, fm = gid * WGM, gsz = (nM - fm) < WGM ? (nM - fm) : WGM;
        u.pm = fm + ((wgid % nig) % gsz); u.pn = (wgid % nig) / gsz; u.e = 0; u.r0 = 0; return true;
    }
    __device__ __forceinline__ unsigned tok(const Unit&, int) const { return 0u; }
};
struct MoeOrder {
    const LAS int* tile0;
    const LAS int* cnt;
    const int* list_tok;
    int NC, nwg, G, c;
    __device__ void init(const LAS int* t0, const LAS int* cn, const int* lt, int NC_, int G_, int c_) { tile0 = t0; cnt = cn; list_tok = lt; NC = NC_; nwg = t0[NEXP] * NC_; G = G_; c = c_; }
    __device__ bool next(int i, Unit& u) const {
        const long L = (long)i * G + c; if (L >= nwg) return false;
        int wgid = (int)L; { const int q = nwg / NXCD, r = nwg % NXCD, xcd = wgid % NXCD, off = wgid / NXCD; wgid = (xcd < r ? xcd * (q + 1) : r * (q + 1) + (xcd - r) * q) + off; }
        int e = 0;
        for (int j = 1; j < NEXP; ++j) if (tile0[j] * NC <= wgid) e = j;
        const int nr = tile0[e + 1] - tile0[e], idx = wgid - tile0[e] * NC;
        const int r = idx % nr, cn = idx / nr;
        u.e = __builtin_amdgcn_readfirstlane(e); u.pm = __builtin_amdgcn_readfirstlane(tile0[e] + r); u.pn = __builtin_amdgcn_readfirstlane(e * NC + cn); u.r0 = __builtin_amdgcn_readfirstlane(r * BM); return true;
    }
    __device__ __forceinline__ unsigned tok(const Unit& u, int row) const { const int p = u.r0 + row; const bool ok = p < cnt[u.e]; return (unsigned)list_tok[u.e * LIST_STRIDE + (ok ? p : 0)]; }
};

template <class Epi, class Sched, bool GATHER, bool ALIGN_EPI, bool SP2, bool FP8>
__device__ __forceinline__ void gemm_phase(LAS unsigned char* lds, const Gemm g, const Sched& S, const Epi& E) {
    const int tid = threadIdx.x, wid = __builtin_amdgcn_readfirstlane(tid >> 6), lane = tid & 63, wr = wid >> 2, wc = wid & 3, fr = lane & 15, fq = lane >> 4;
    const int K = g.K, nt = K / BK;
    u32x2 vA0, vA1; unsigned voffB[2];
    int Rr[2], Cc[2];
#pragma unroll
    for (int i = 0; i < 2; ++i) { int R, C; stage_rc(tid * 16 + i * 8192, R, C); Rr[i] = R; Cc[i] = C; const int Rb = (R & ~31) + perm32(R & 31); voffB[i] = (unsigned)(Rb * K + C) * 2u; }
    const int kstep = BK * 2;
    const int hstep = HALF * K * 2;
    const int tstep = 2 * hstep;
    const unsigned ldsw = (unsigned)wid * 1024u;
    const int aoff = lds_byte(wr * 64 + fr, fq * 8), boff = lds_byte(wc * 32 + fr, fq * 8);
    const __amdgpu_buffer_rsrc_t rsA = __builtin_amdgcn_make_buffer_rsrc((void*)g.A, 0, 0xFFFFFFF0u, 0x00020000);
    const __amdgpu_buffer_rsrc_t rsB = __builtin_amdgcn_make_buffer_rsrc((void*)g.Bt, 0, 0xFFFFFFF0u, 0x00020000);
#define PG8_OFFA(u, _row, _i) (GATHER ? (S.tok(u, _row) * (unsigned)(K * 2) + (unsigned)(Cc[_i] * 2)) : (unsigned)((_row) * K + Cc[_i]) * 2u)
#define PG8_SETA(d0, d1, u) do { d0.x = PG8_OFFA(u, Rr[0], 0); d0.y = PG8_OFFA(u, Rr[1], 1); d1.x = PG8_OFFA(u, HALF + Rr[0], 0); d1.y = PG8_OFFA(u, HALF + Rr[1], 1); } while (0)
#define PG8_SA(b, h) (((b) * 2 + (h)) * HTB)
#define PG8_SB(b, h) ((4 + (b) * 2 + (h)) * HTB)
#define PG8_STAGE_A(bufoff, soff, voff) do { _Pragma("unroll") for (int _i = 0; _i < 2; ++_i) \
        __builtin_amdgcn_raw_ptr_buffer_load_lds(rsA, (LAS void*)(lds + (bufoff) + ldsw + _i * 8192), 16, (voff)[_i], (soff), 0, 0); } while (0)
#define PG8_STAGE_B(bufoff, soff) do { _Pragma("unroll") for (int _i = 0; _i < 2; ++_i) \
        __builtin_amdgcn_raw_ptr_buffer_load_lds(rsB, (LAS void*)(lds + (bufoff) + ldsw + _i * 8192), 16, voffB[_i], (soff), 0, 0); } while (0)
#define PG8_LD8(base_) __builtin_shufflevector(*(const LAS i32x4*)(base_), *(const LAS i32x4*)((base_) + 1024), 0, 1, 2, 3, 4, 5, 6, 7)
#define PG8_LDA(dst, b, h) do { _Pragma("unroll") for (int m = 0; m < 4; ++m) dst[m] = PG8_LD8(lds + PG8_SA(b, h) + aoff + m * 2048); } while (0)
#define PG8_LDB(dst, b, h) do { _Pragma("unroll") for (int n = 0; n < 2; ++n) dst[n] = PG8_LD8(lds + PG8_SB(b, h) + boff + n * 2048); } while (0)
#define PG8_LO(v) __builtin_bit_cast(bf16x8, __builtin_shufflevector(v, v, 0, 1, 2, 3))
#define PG8_HI(v) __builtin_bit_cast(bf16x8, __builtin_shufflevector(v, v, 4, 5, 6, 7))
#define PG8_MMA(ai, bj, At, Bt) do { __builtin_amdgcn_s_setprio(1); _Pragma("unroll") for (int m = 0; m < 4; ++m) _Pragma("unroll") for (int n = 0; n < 2; ++n) { \
        if constexpr (FP8) asm volatile("v_mfma_f32_16x16x128_f8f6f4 %0, %1, %2, %0" : "+v"(acc[ai][bj][m][n]) : "v"(Bt[n]), "v"(At[m])); \
        else { asm volatile("v_mfma_f32_16x16x32_bf16 %0, %1, %2, %0" : "+v"(acc[ai][bj][m][n]) : "v"(PG8_LO(Bt[n])), "v"(PG8_LO(At[m]))); \
               asm volatile("v_mfma_f32_16x16x32_bf16 %0, %1, %2, %0" : "+v"(acc[ai][bj][m][n]) : "v"(PG8_HI(Bt[n])), "v"(PG8_HI(At[m]))); } } \
        __builtin_amdgcn_s_setprio(0); } while (0)
#define PG8_WAIT_V(n) asm volatile("s_waitcnt vmcnt(" #n ")" ::: "memory")
#define PG8_WAIT_L(n) asm volatile("s_waitcnt lgkmcnt(" #n ")" ::: "memory")
#define PG8_BAR __builtin_amdgcn_s_barrier()
#define PG8_SCHED __builtin_amdgcn_sched_barrier(0)
    Unit cur, nxt; int ui = 0;
    if (!S.next(0, cur)) return;
    typename Epi::Pre pre{};
    f32x4 acc[2][2][4][2];
#pragma unroll
    for (int a = 0; a < 2; ++a)
#pragma unroll
        for (int b = 0; b < 2; ++b)
#pragma unroll
            for (int m = 0; m < 4; ++m)
#pragma unroll
                for (int n = 0; n < 2; ++n) acc[a][b][m][n] = (f32x4){0.f, 0.f, 0.f, 0.f};
    i32x8 At[4], B0[2], B1[2];
    int cA = GATHER ? 0 : cur.pm * tstep, cB = cur.pn * tstep;
    PG8_SETA(vA0, vA1, cur);
    if constexpr (SP2) {
        PG8_STAGE_B(PG8_SB(0, 0), cB); PG8_STAGE_B(PG8_SB(0, 1), cB + hstep); PG8_STAGE_A(PG8_SA(0, 0), cA, vA0); PG8_STAGE_A(PG8_SA(0, 1), cA, vA1);
        if (wr == 1) PG8_BAR;
        PG8_WAIT_V(2); PG8_BAR;
        PG8_STAGE_B(PG8_SB(1, 0), cB + kstep); PG8_STAGE_A(PG8_SA(1, 0), cA + kstep, vA0); PG8_STAGE_B(PG8_SB(1, 1), cB + hstep + kstep);
        PG8_WAIT_V(6); PG8_BAR;
    } else {
        PG8_STAGE_B(PG8_SB(0, 0), cB); PG8_STAGE_A(PG8_SA(0, 0), cA, vA0); PG8_STAGE_B(PG8_SB(0, 1), cB + hstep); PG8_STAGE_A(PG8_SA(0, 1), cA, vA1);
        if (wr == 1) PG8_BAR;
        PG8_WAIT_V(4); PG8_BAR;
        PG8_STAGE_B(PG8_SB(1, 0), cB + kstep); PG8_STAGE_A(PG8_SA(1, 0), cA + kstep, vA0); PG8_STAGE_B(PG8_SB(1, 1), cB + hstep + kstep);
        PG8_WAIT_V(6); PG8_BAR;
    }
    for (;;) {
        const bool has_next = S.next(ui + 1, nxt);
        const int nA = has_next ? (GATHER ? 0 : nxt.pm * tstep) : cA, nB = has_next ? nxt.pn * tstep : cB;
        u32x2 nvA0 = vA0, nvA1 = vA1;
        for (int t = 0; t < nt; t += 2) {
            const bool last = (t == nt - 2);
            if (last) pre = E.prefetch(cur, wr, wc, fr, fq);
            u32x2 va2x0 = vA0, va2x1 = vA1;
            if constexpr (GATHER) {
                if (last && has_next) { asm volatile("" : "+v"(nvA0), "+v"(nvA1));
                                        nvA0.x = nvA0.x * (unsigned)(K * 2) + (unsigned)(Cc[0] * 2); nvA0.y = nvA0.y * (unsigned)(K * 2) + (unsigned)(Cc[1] * 2);
                                        nvA1.x = nvA1.x * (unsigned)(K * 2) + (unsigned)(Cc[0] * 2); nvA1.y = nvA1.y * (unsigned)(K * 2) + (unsigned)(Cc[1] * 2); va2x0 = nvA0; va2x1 = nvA1; }
                if (t == nt - 4 && has_next) { nvA0.x = S.tok(nxt, Rr[0]); nvA0.y = S.tok(nxt, Rr[1]); nvA1.x = S.tok(nxt, HALF + Rr[0]); nvA1.y = S.tok(nxt, HALF + Rr[1]); }
            }
            const int a1 = cA + (t + 1) * kstep;
            const int a2 = last ? nA : cA + (t + 2) * kstep, b2 = last ? nB : cB + (t + 2) * kstep;
            const int a3 = a2 + kstep, b3 = b2 + kstep;
            const u32x2 va20 = va2x0, va21 = va2x1;
            if constexpr (SP2) {
            PG8_LDB(B0, 0, 0); PG8_LDB(B1, 0, 1); PG8_SCHED; PG8_LDA(At, 0, 0); PG8_STAGE_A(PG8_SA(1, 1), a1, vA1);
            PG8_WAIT_V(8); PG8_WAIT_L(0); PG8_BAR; PG8_MMA(0, 0, At, B0); PG8_MMA(0, 1, At, B1); PG8_BAR; PG8_SCHED;
            PG8_LDA(At, 0, 1); PG8_STAGE_B(PG8_SB(0, 0), b2); PG8_STAGE_B(PG8_SB(0, 1), b2 + hstep); PG8_STAGE_A(PG8_SA(0, 0), a2, va20);
            PG8_WAIT_V(8); PG8_WAIT_L(0); PG8_BAR; PG8_MMA(1, 0, At, B0); PG8_MMA(1, 1, At, B1); PG8_BAR; PG8_SCHED;
            PG8_LDB(B0, 1, 0); PG8_LDB(B1, 1, 1); PG8_SCHED; PG8_LDA(At, 1, 0); PG8_STAGE_A(PG8_SA(0, 1), a2, va21);
            PG8_WAIT_V(8); PG8_WAIT_L(0); PG8_BAR; PG8_MMA(0, 0, At, B0); PG8_MMA(0, 1, At, B1); PG8_BAR; PG8_SCHED;
            PG8_LDA(At, 1, 1); PG8_STAGE_B(PG8_SB(1, 0), b3); PG8_STAGE_B(PG8_SB(1, 1), b3 + hstep); PG8_STAGE_A(PG8_SA(1, 0), a3, va20);
            PG8_WAIT_V(8); PG8_WAIT_L(0); PG8_BAR; PG8_MMA(1, 0, At, B0); PG8_MMA(1, 1, At, B1); PG8_BAR; PG8_SCHED;
            } else {
            PG8_LDB(B0, 0, 0); PG8_SCHED; PG8_LDA(At, 0, 0); PG8_STAGE_A(PG8_SA(1, 1), a1, vA1);
            PG8_WAIT_L(8); PG8_BAR; PG8_WAIT_L(0); PG8_MMA(0, 0, At, B0); PG8_BAR; PG8_SCHED;
            PG8_LDB(B1, 0, 1); PG8_STAGE_B(PG8_SB(0, 0), b2);
            PG8_BAR; PG8_WAIT_L(0); PG8_MMA(0, 1, At, B1); PG8_BAR;
            PG8_LDA(At, 0, 1); PG8_STAGE_A(PG8_SA(0, 0), a2, va20);
            PG8_BAR; PG8_WAIT_L(0); PG8_MMA(1, 0, At, B0); PG8_BAR; PG8_SCHED;
            PG8_STAGE_B(PG8_SB(0, 1), b2 + hstep);
            PG8_WAIT_V(6); PG8_BAR; PG8_MMA(1, 1, At, B1); PG8_BAR;
            PG8_LDB(B0, 1, 0); PG8_SCHED; PG8_LDA(At, 1, 0); PG8_STAGE_A(PG8_SA(0, 1), a2, va21);
            PG8_WAIT_L(8); PG8_BAR; PG8_WAIT_L(0); PG8_MMA(0, 0, At, B0); PG8_BAR; PG8_SCHED;
            PG8_LDB(B1, 1, 1); PG8_STAGE_B(PG8_SB(1, 0), b3);
            PG8_BAR; PG8_WAIT_L(0); PG8_MMA(0, 1, At, B1); PG8_BAR;
            PG8_LDA(At, 1, 1); PG8_STAGE_A(PG8_SA(1, 0), a3, va20);
            PG8_BAR; PG8_WAIT_L(0); PG8_MMA(1, 0, At, B0); PG8_BAR; PG8_SCHED;
            PG8_STAGE_B(PG8_SB(1, 1), b3 + hstep);
            PG8_WAIT_V(6); PG8_BAR; PG8_MMA(1, 1, At, B1); PG8_BAR;
            }
        }
        if constexpr (ALIGN_EPI) { if (wr == 0) PG8_BAR; }
        {
            asm volatile("s_nop 15\n\ts_nop 3" : "+v"(acc[0][0][0][0]), "+v"(acc[0][0][0][1]), "+v"(acc[0][0][1][0]), "+v"(acc[0][0][1][1]), "+v"(acc[0][0][2][0]), "+v"(acc[0][0][2][1]), "+v"(acc[0][0][3][0]), "+v"(acc[0][0][3][1]));
            asm volatile("" : "+v"(acc[0][1][0][0]), "+v"(acc[0][1][0][1]), "+v"(acc[0][1][1][0]), "+v"(acc[0][1][1][1]), "+v"(acc[0][1][2][0]), "+v"(acc[0][1][2][1]), "+v"(acc[0][1][3][0]), "+v"(acc[0][1][3][1]));
            asm volatile("" : "+v"(acc[1][0][0][0]), "+v"(acc[1][0][0][1]), "+v"(acc[1][0][1][0]), "+v"(acc[1][0][1][1]), "+v"(acc[1][0][2][0]), "+v"(acc[1][0][2][1]), "+v"(acc[1][0][3][0]), "+v"(acc[1][0][3][1]));
            asm volatile("" : "+v"(acc[1][1][0][0]), "+v"(acc[1][1][0][1]), "+v"(acc[1][1][1][0]), "+v"(acc[1][1][1][1]), "+v"(acc[1][1][2][0]), "+v"(acc[1][1][2][1]), "+v"(acc[1][1][3][0]), "+v"(acc[1][1][3][1]));
        }
        { Unit eu = cur; asm volatile("" : "+s"(eu.pm), "+s"(eu.pn), "+s"(eu.e), "+s"(eu.r0));
          int tid2 = threadIdx.x; asm volatile("" : "+v"(tid2));
          const int wid2 = __builtin_amdgcn_readfirstlane(tid2 >> 6), lane2 = tid2 & 63;
          E(acc, eu, pre, wid2 >> 2, wid2 & 3, lane2 & 15, lane2 >> 4); }
        if (!has_next) break;
#pragma unroll
        for (int a = 0; a < 2; ++a)
#pragma unroll
            for (int b = 0; b < 2; ++b)
#pragma unroll
                for (int m = 0; m < 4; ++m)
#pragma unroll
                    for (int n = 0; n < 2; ++n) acc[a][b][m][n] = (f32x4){0.f, 0.f, 0.f, 0.f};
        cur = nxt; cA = nA; cB = nB; ++ui;
        vA0 = nvA0; vA1 = nvA1;
        if constexpr (ALIGN_EPI) { if (wr == 1) PG8_BAR; }
    }
    PG8_WAIT_V(0);
    if constexpr (!ALIGN_EPI) { if (wr == 0) PG8_BAR; }
    PG8_BAR;
#undef PG8_SETA
#undef PG8_OFFA
#undef PG8_SA
#undef PG8_SB
#undef PG8_STAGE_A
#undef PG8_STAGE_B
#undef PG8_LDA
#undef PG8_LD8
#undef PG8_LO
#undef PG8_HI
#undef PG8_LDB
#undef PG8_MMA
#undef PG8_WAIT_V
#undef PG8_WAIT_L
#undef PG8_BAR
#undef PG8_SCHED
}
}

struct EpiProj {
    bf16_t* O; const float* rstd;
    static constexpr int NSTORE = 16;
    struct Pre { f32x4 ra, rb; };
    __device__ __forceinline__ Pre prefetch(const pg8::Unit& u, int wr, int, int fr, int) const { Pre q; const int row0 = u.pm * 256 + wr * 64 + fr;
#pragma unroll
        for (int i = 0; i < 4; ++i) { q.ra[i] = rstd[row0 + i * 16]; q.rb[i] = rstd[row0 + 128 + i * 16]; }
        return q; }
    __device__ __forceinline__ void operator()(const f32x4 (&acc)[2][2][4][2], const pg8::Unit& u, const Pre& pre, int wr, int wc, int fr, int fq) const {
        const int row0 = u.pm * 256 + wr * 64 + fr, col0 = u.pn * 256 + wc * 32 + 8 * fq;
        float rsv[8];
#pragma unroll
        for (int i = 0; i < 4; ++i) { rsv[i] = pre.ra[i]; rsv[4 + i] = pre.rb[i]; }
#pragma unroll
        for (int ai = 0; ai < 2; ++ai)
#pragma unroll
            for (int m = 0; m < 4; ++m) { const int row = row0 + ai * 128 + m * 16; const float rs = rsv[ai * 4 + m]; bf16_t* rowp = O + (size_t)row * NPROJ + col0;
#pragma unroll
                for (int bj = 0; bj < 2; ++bj) { const f32x4 v0 = acc[ai][bj][m][0] * rs, v1 = acc[ai][bj][m][1] * rs;
                    u32x4 w; w.x = cvt_pk_bf16(v0[0], v0[1]); w.y = cvt_pk_bf16(v0[2], v0[3]); w.z = cvt_pk_bf16(v1[0], v1[1]); w.w = cvt_pk_bf16(v1[2], v1[3]);
                    *(u32x4*)(rowp + bj * 128) = w; } }
    }
};
struct EpiOut {
    const float* X; float* X1; unsigned char* X1b;
    static constexpr int NSTORE = 48;
    struct Pre { int none; };
    __device__ __forceinline__ Pre prefetch(const pg8::Unit&, int, int, int, int) const { return Pre{0}; }
    __device__ __forceinline__ void operator()(const f32x4 (&acc)[2][2][4][2], const pg8::Unit& u, const Pre&, int wr, int wc, int fr, int fq) const {
        const int row0 = u.pm * 256 + wr * 64 + fr, col0 = u.pn * 256 + wc * 32 + 8 * fq;
        f32x4 xa[2][2], xb[2][2];
#define EPO_LOAD(dst, g) do { const size_t off_ = (size_t)(row0 + ((g) >> 2) * 128 + ((g) & 3) * 16) * DM + col0; \
        _Pragma("unroll") for (int bj_ = 0; bj_ < 2; ++bj_) { dst[bj_][0] = *(const f32x4*)(X + off_ + bj_ * 128); dst[bj_][1] = *(const f32x4*)(X + off_ + bj_ * 128 + 4); } } while (0)
#define EPO_DO(src, g) do { const int ai_ = (g) >> 2, m_ = (g) & 3; const size_t off_ = (size_t)(row0 + ai_ * 128 + m_ * 16) * DM + col0; \
        _Pragma("unroll") for (int bj_ = 0; bj_ < 2; ++bj_) { const f32x4 v0 = acc[ai_][bj_][m_][0] + src[bj_][0], v1 = acc[ai_][bj_][m_][1] + src[bj_][1]; \
            *(f32x4*)(X1 + off_ + bj_ * 128) = v0; *(f32x4*)(X1 + off_ + bj_ * 128 + 4) = v1; \
            u32x2 w_; w_.x = cvt4_fp8(v0[0], v0[1], v0[2], v0[3]); w_.y = cvt4_fp8(v1[0], v1[1], v1[2], v1[3]); *(u32x2*)(X1b + off_ + bj_ * 128) = w_; } } while (0)
        EPO_LOAD(xa, 0);
        EPO_LOAD(xb, 1); __builtin_amdgcn_sched_barrier(0); EPO_DO(xa, 0); __builtin_amdgcn_sched_barrier(0);
        EPO_LOAD(xa, 2); __builtin_amdgcn_sched_barrier(0); EPO_DO(xb, 1); __builtin_amdgcn_sched_barrier(0);
        EPO_LOAD(xb, 3); __builtin_amdgcn_sched_barrier(0); EPO_DO(xa, 2); __builtin_amdgcn_sched_barrier(0);
        EPO_LOAD(xa, 4); __builtin_amdgcn_sched_barrier(0); EPO_DO(xb, 3); __builtin_amdgcn_sched_barrier(0);
        EPO_LOAD(xb, 5); __builtin_amdgcn_sched_barrier(0); EPO_DO(xa, 4); __builtin_amdgcn_sched_barrier(0);
        EPO_LOAD(xa, 6); __builtin_amdgcn_sched_barrier(0); EPO_DO(xb, 5); __builtin_amdgcn_sched_barrier(0);
        EPO_LOAD(xb, 7); __builtin_amdgcn_sched_barrier(0); EPO_DO(xa, 6); __builtin_amdgcn_sched_barrier(0);
        EPO_DO(xb, 7);
#undef EPO_LOAD
#undef EPO_DO
    }
};
struct EpiMoe1 {
    unsigned char* ACT; const float* bg; const float* bu; const float* list_rs; const LAS int* cnt;
    static constexpr int NSTORE = 8;
    struct Pre { f32x4 g0, g1, u0, u1; };
    __device__ __forceinline__ Pre prefetch(const pg8::Unit& u, int wr, int wc, int fr, int fq) const { Pre q; const int e = u.e, cn = u.pn - e * 16, col = cn * 128 + wc * 32 + 8 * fq, ce = cnt[e];
        q.g0 = *(const f32x4*)(bg + e * DFF + col); q.g1 = *(const f32x4*)(bg + e * DFF + col + 4); q.u0 = *(const f32x4*)(bu + e * DFF + col); q.u1 = *(const f32x4*)(bu + e * DFF + col + 4);
        (void)ce; (void)wr; (void)fr; return q; }
    __device__ __forceinline__ void operator()(const f32x4 (&acc)[2][2][4][2], const pg8::Unit& u, const Pre& pre, int wr, int wc, int fr, int fq) const {
        const int e = u.e, cn = u.pn - e * 16, col = cn * 128 + wc * 32 + 8 * fq, ce = cnt[e];
        const f32x4 g0 = pre.g0, g1 = pre.g1, u0 = pre.u0, u1 = pre.u1;
        float rsv[8];
#pragma unroll
        for (int i = 0; i < 8; ++i) { const int p = u.r0 + (i >> 2) * 128 + wr * 64 + (i & 3) * 16 + fr; rsv[i] = list_rs[e * LIST_STRIDE + (p < ce ? p : 0)]; }
#pragma unroll
        for (int ai = 0; ai < 2; ++ai)
#pragma unroll
            for (int m = 0; m < 4; ++m) { const int rit = ai * 128 + wr * 64 + m * 16 + fr, p = u.r0 + rit; const float rs = (p < ce) ? rsv[ai * 4 + m] * 0.015625f : 0.f;
                f32x4 gt0 = acc[ai][0][m][0] * rs + g0, gt1 = acc[ai][0][m][1] * rs + g1, up0 = acc[ai][1][m][0] * rs + u0, up1 = acc[ai][1][m][1] * rs + u1;
                float o[8];
#pragma unroll
                for (int j = 0; j < 4; ++j) { float gv = fminf(gt0[j], 7.0f), uv = fminf(fmaxf(up0[j], -7.0f), 7.0f); o[j] = (uv + 1.0f) * (gv * sig1702_(gv));
                    gv = fminf(gt1[j], 7.0f); uv = fminf(fmaxf(up1[j], -7.0f), 7.0f); o[4 + j] = (uv + 1.0f) * (gv * sig1702_(gv)); }
                u32x2 w; w.x = cvt4_fp8(o[0], o[1], o[2], o[3]); w.y = cvt4_fp8(o[4], o[5], o[6], o[7]);
                *(u32x2*)(ACT + (size_t)(u.pm * 256 + rit) * DFF + col) = w; }
    }
};
struct EpiMoe2 {
    unsigned char* YS; const float* bd;
    static constexpr int NSTORE = 16;
    struct Pre { f32x4 bv[2][2]; };
    __device__ __forceinline__ Pre prefetch(const pg8::Unit& u, int wr, int wc, int fr, int fq) const { Pre q; const int e = u.e, cn = u.pn - e * 8, col0 = cn * 256 + wc * 32 + 8 * fq;
#pragma unroll
        for (int bj = 0; bj < 2; ++bj) { q.bv[bj][0] = *(const f32x4*)(bd + e * DM + col0 + bj * 128); q.bv[bj][1] = *(const f32x4*)(bd + e * DM + col0 + bj * 128 + 4); }
        return q; }
    __device__ __forceinline__ void operator()(const f32x4 (&acc)[2][2][4][2], const pg8::Unit& u, const Pre& pre, int wr, int wc, int fr, int fq) const {
        const int e = u.e, cn = u.pn - e * 8, col0 = cn * 256 + wc * 32 + 8 * fq;
        f32x4 bv[2][2];
#pragma unroll
        for (int bj = 0; bj < 2; ++bj) { bv[bj][0] = pre.bv[bj][0]; bv[bj][1] = pre.bv[bj][1]; }
#pragma unroll
        for (int ai = 0; ai < 2; ++ai)
#pragma unroll
            for (int m = 0; m < 4; ++m) { unsigned char* rowp = YS + (size_t)(u.pm * 256 + ai * 128 + wr * 64 + m * 16 + fr) * DM + col0;
#pragma unroll
                for (int bj = 0; bj < 2; ++bj) { const f32x4 v0 = acc[ai][bj][m][0] * 0.015625f + bv[bj][0], v1 = acc[ai][bj][m][1] * 0.015625f + bv[bj][1];
                    u32x2 w; w.x = cvt4_fp8(v0[0], v0[1], v0[2], v0[3]); w.y = cvt4_fp8(v1[0], v1[1], v1[2], v1[3]);
                    *(u32x2*)(rowp + bj * 128) = w; } }
    }
};

#define XB_TMO      128
#define XB_XCNT(j)  (256  + 64 * (j))
#define XB_XSUB(j)  (1280 + 64 * (j))
#define XB_XGEN(j)  (2304 + 64 * (j))
#define XB_TOP      3328
#define XB_TOPGEN   3392
#define XCD_BAR_WORDS 3456
#define XB_SPIN_CAP (1u << 18)
__device__ __forceinline__ unsigned xb_ld(unsigned* p)              { return __hip_atomic_load(p, __ATOMIC_RELAXED, __HIP_MEMORY_SCOPE_AGENT); }
__device__ __forceinline__ unsigned xb_add(unsigned* p, unsigned v) { return __hip_atomic_fetch_add(p, v, __ATOMIC_RELAXED, __HIP_MEMORY_SCOPE_AGENT); }
__device__ __forceinline__ unsigned xb_xcc_id() { return (unsigned)__builtin_amdgcn_s_getreg((3 << 11) | 20) & 0xFu; }
#define XB_SPIN(cond, bar) do { unsigned _sp = 0; while (cond) { __builtin_amdgcn_s_sleep(1); \
    if ((++_sp & 255u) == 0u) { if (xb_ld(&(bar)[XB_TMO])) break; if (_sp > XB_SPIN_CAP) { atomicAdd(&(bar)[XB_TMO], 1u); break; } } } } while (0)
struct XcdBarrier { unsigned* bar; unsigned x; volatile LAS unsigned* st; };
__device__ __forceinline__ XcdBarrier xcd_barrier_post(unsigned* bar, volatile LAS unsigned* st) {
    XcdBarrier b; b.bar = bar; b.x = xb_xcc_id(); b.st = st;
    if (threadIdx.x == 0) (void)xb_add(&bar[XB_XCNT(b.x)], 1u);
    return b;
}
__device__ __forceinline__ void xcd_barrier_complete(unsigned* bar, unsigned x, unsigned& nloc, unsigned& nx) {
    const unsigned G = gridDim.x * gridDim.y * gridDim.z;
    unsigned sum, cnt, mine, sp = 0u;
    for (;;) {
        sum = 0u; cnt = 0u; mine = 0u;
#pragma unroll
        for (unsigned j = 0; j < 16; ++j) { const unsigned c = xb_ld(&bar[XB_XCNT(j)]); sum += c; cnt += (c > 0u) ? 1u : 0u; mine = (j == x) ? c : mine; }
        if (sum == G) break;
        __builtin_amdgcn_s_sleep(1);
        if ((++sp & 255u) == 0u) { if (xb_ld(&bar[XB_TMO])) break; if (sp > XB_SPIN_CAP) { atomicAdd(&bar[XB_TMO], 1u); break; } }
    }
    nloc = mine > 0u ? mine : 1u; nx = cnt > 0u ? cnt : 1u;
}
__device__ __forceinline__ void xcd_barrier(const XcdBarrier& b) {
    asm volatile("s_waitcnt vmcnt(0)" ::: "memory");
    __syncthreads();
    if (threadIdx.x == 0) {
        unsigned* bar = b.bar;
        __builtin_amdgcn_s_waitcnt(0);
        unsigned nloc = b.st[0], nx = b.st[1];
        if (nloc == 0u) { xcd_barrier_complete(bar, b.x, nloc, nx); b.st[0] = nloc; b.st[1] = nx; }
        const unsigned old = xb_add(&bar[XB_XSUB(b.x)], 1u);
        const unsigned gen = old / nloc;
        if (old + 1u == (gen + 1u) * nloc) {
            __builtin_amdgcn_fence(__ATOMIC_RELEASE, "agent");
            asm volatile("s_waitcnt vmcnt(0)" ::: "memory");
            const unsigned og = xb_add(&bar[XB_TOP], 1u);
            const unsigned tg = og / nx;
            if (og + 1u == (tg + 1u) * nx) xb_add(&bar[XB_TOPGEN], 1u);
            else XB_SPIN(xb_ld(&bar[XB_TOPGEN]) == tg, bar);
            __builtin_amdgcn_fence(__ATOMIC_ACQUIRE, "agent");
            xb_add(&bar[XB_XGEN(b.x)], 1u);
            asm volatile("s_waitcnt vmcnt(0)" ::: "memory");
        } else {
            XB_SPIN(xb_ld(&bar[XB_XGEN(b.x)]) == gen, bar);
            __builtin_amdgcn_fence(__ATOMIC_ACQUIRE, "agent");
            asm volatile("s_waitcnt vmcnt(0)" ::: "memory");
        }
    }
    __syncthreads();
}

constexpr size_t MiB = 1u << 20;
constexpr size_t WS_CTL = 0, CTL_ZERO_BYTES = 1 * MiB;
constexpr int CW_BAR = 4096;
constexpr int CW_CNT = 64;
constexpr size_t WS_RSTD1 = 1 * MiB;
constexpr size_t WS_GATES = WS_RSTD1 + 64 * 1024;
constexpr size_t WS_RSTD2 = WS_GATES + 512 * 1024;
constexpr size_t WS_TOKE  = WS_RSTD2 + 64 * 1024;
constexpr size_t WS_TOKP  = WS_TOKE + 256 * 1024;
constexpr size_t WS_TOKG  = WS_TOKP + 256 * 1024;
constexpr size_t WS_LTOK  = 3 * MiB;
constexpr size_t WS_LRS   = 5 * MiB;
constexpr size_t WS_DVEC  = 7 * MiB;
constexpr size_t WS_DN    = 8 * MiB;
constexpr size_t WS_NST   = 8 * MiB + 512 * 1024;
constexpr size_t WS_MSC   = 9 * MiB;
constexpr size_t WS_MST   = 9 * MiB + 64 * 1024;
constexpr size_t WS_WGU   = 16 * MiB;
constexpr size_t WS_WDN   = WS_WGU + 512 * MiB;
constexpr size_t WS_WOUT  = WS_WDN + 256 * MiB;
constexpr size_t WS_X1    = WS_WOUT + 8 * MiB;
constexpr size_t WS_X1B   = WS_X1 + 128 * MiB;
constexpr size_t WS_S0    = WS_X1B + 64 * MiB;
constexpr size_t WS_XB    = WS_S0;
constexpr size_t WS_WIN   = WS_S0 + 64 * MiB;
constexpr size_t WS_PROJ  = WS_S0 + 96 * MiB;
constexpr size_t WS_DS    = WS_S0 + 320 * MiB;
constexpr size_t WS_DC    = WS_S0 + 448 * MiB;
constexpr size_t WS_SST   = WS_S0;
constexpr size_t WS_CST   = WS_S0 + 576 * MiB;
constexpr size_t WS_MIX   = WS_S0 + 640 * MiB;
constexpr size_t WS_ACT   = WS_S0;
constexpr size_t WS_YS    = WS_S0 + 288 * MiB;
constexpr size_t WS_END   = WS_S0 + 704 * MiB;

constexpr int RING_BYTES = 131072;
constexpr int LDSCTL_OFF = 162816;
constexpr int L_MISC = LDSCTL_OFF;
constexpr int L_TILE0 = LDSCTL_OFF + 256;
constexpr int L_CNT = LDSCTL_OFF + 512;
constexpr int L_HIST = LDSCTL_OFF + 768;
constexpr int LDS_BYTES = 163840;

struct Params {
    const float* in[21]; float* out; unsigned char* ws; int ph_lo, ph_hi, li, pad;
};
struct Frame { LAS unsigned char* lds; int tid, lane, wave, G, vcu; };

__device__ __forceinline__ float wave_sum(float v) {
#pragma unroll
    for (int o = 1; o < 64; o <<= 1) v += __shfl_xor(v, o);
    return v;
}

__device__ __forceinline__ void p0_transpose_item(const float* W, int ldw, int k0, int n0, bf16_t* WT, int K, int drow0, const float* sc, LAS float* scr, int lane) {
#pragma unroll 8
    for (int i = 0; i < 32; ++i) { const int kk = 2 * i + (lane >> 5); scr[kk * 33 + (lane & 31)] = W[(size_t)(k0 + kk) * ldw + n0 + (lane & 31)]; }
    const int c = lane & 7;
    float s8[8];
#pragma unroll
    for (int j = 0; j < 8; ++j) s8[j] = sc ? sc[k0 + 8 * c + j] : 1.0f;
    asm volatile("s_waitcnt lgkmcnt(0)" ::: "memory");
#pragma unroll
    for (int j = 0; j < 4; ++j) { const int n = (lane >> 3) + 8 * j; const LAS float* s = scr + (8 * c) * 33 + n;
        u32x4 o; o.x = cvt_pk_bf16(s[0 * 33] * s8[0], s[1 * 33] * s8[1]); o.y = cvt_pk_bf16(s[2 * 33] * s8[2], s[3 * 33] * s8[3]); o.z = cvt_pk_bf16(s[4 * 33] * s8[4], s[5 * 33] * s8[5]); o.w = cvt_pk_bf16(s[6 * 33] * s8[6], s[7 * 33] * s8[7]);
        *(u32x4*)(WT + (size_t)(drow0 + n) * K + k0 + 8 * c) = o; }
    asm volatile("s_waitcnt lgkmcnt(0)" ::: "memory");
}

__device__ __forceinline__ void p0_transpose_item_bf16(const float* W, int ldw, int k0, int n0, bf16_t* WT, int K, int drow0, const float* sc, LAS unsigned char* tile, int lane) {
    const int kq = lane >> 4, nq = lane & 15;
    const float* src = W + (size_t)(k0 + 4 * kq) * ldw + n0 + 4 * nq;
#pragma unroll
    for (int hb = 0; hb < 2; ++hb) {
        f32x4 v[4][4], sv[4];
        const float* scp = sc ? sc + k0 + 64 * hb + 4 * kq : src;
#pragma unroll
        for (int i = 0; i < 4; ++i) sv[i] = *(const f32x4*)(scp + (sc ? 16 * i : 0));
#pragma unroll
        for (int i = 0; i < 4; ++i)
#pragma unroll
            for (int j = 0; j < 4; ++j) v[i][j] = *(const f32x4*)(src + (size_t)(64 * hb + 16 * i + j) * ldw);
#pragma unroll
        for (int i = 0; i < 4; ++i) {
            const f32x4 s4 = sc ? sv[i] : (f32x4){1.f, 1.f, 1.f, 1.f};
#pragma unroll
            for (int nn = 0; nn < 4; ++nn) { u32x2 t; t.x = cvt_pk_bf16(v[i][0][nn] * s4[0], v[i][1][nn] * s4[1]); t.y = cvt_pk_bf16(v[i][2][nn] * s4[2], v[i][3][nn] * s4[3]);
                const int chunk = 2 * (4 * hb + i) + (kq >> 1);
                *(LAS u32x2*)(tile + (4 * nq + nn) * 256 + ((chunk ^ nq) << 4) + ((kq & 1) << 3)) = t; }
        }
    }
    asm volatile("s_waitcnt lgkmcnt(0)" ::: "memory");
#pragma unroll
    for (int r = 0; r < 16; ++r) { const int n = (lane >> 4) + 4 * r, c = lane & 15;
        const u32x4 o = *(const LAS u32x4*)(tile + n * 256 + ((c ^ ((n >> 2) & 15)) << 4));
        *(u32x4*)(WT + (size_t)(drow0 + n) * K + k0 + 8 * c) = o; }
    asm volatile("s_waitcnt lgkmcnt(0)" ::: "memory");
}

struct ConvItem { const float* W; unsigned char* WT; int sco; int k0, n0, drow0; };
__device__ __forceinline__ ConvItem conv_item(const Params& p, int it) {
    constexpr int I_E = (DM / 128) * (DFF / 64);
    const bool dn = it >= NEXP * 2 * I_E; const int j = dn ? it - NEXP * 2 * I_E : it;
    const int e = dn ? j / I_E : j / (2 * I_E), which = dn ? 2 : (j % (2 * I_E)) / I_E, r3 = j % I_E, nb = r3 % (DFF / 64), kb = r3 / (DFF / 64), n0 = nb * 64;
    ConvItem c; c.k0 = kb * 128; c.n0 = n0;
    if (which == 0) { c.W = p.in[14] + (size_t)e * DM * DFF; c.WT = (unsigned char*)(p.ws + WS_WGU) + (size_t)e * 4096 * DM; c.sco = 0; c.drow0 = (n0 >> 7) * 256 + (n0 & 127); }
    else if (which == 1) { c.W = p.in[16] + (size_t)e * DM * DFF; c.WT = (unsigned char*)(p.ws + WS_WGU) + (size_t)e * 4096 * DM; c.sco = 0; c.drow0 = (n0 >> 7) * 256 + 128 + (n0 & 127); }
    else { c.W = p.in[18] + (size_t)e * DFF * DM; c.WT = (unsigned char*)(p.ws + WS_WDN) + (size_t)e * DM * DFF; c.sco = 8192; c.drow0 = n0; }
    return c;
}
#define CONV_LOAD(dst, ci, half) do { const float* src_ = (ci).W + (size_t)((ci).k0 + 64 * (half) + 4 * kq) * 2048 + (ci).n0 + 4 * nq; \
        _Pragma("unroll") for (int i_ = 0; i_ < 4; ++i_) _Pragma("unroll") for (int j_ = 0; j_ < 4; ++j_) dst[i_][j_] = __builtin_nontemporal_load((const f32x4*)(src_ + (size_t)(16 * i_ + j_) * 2048)); } while (0)
#define CONV_PACK(srcv, ci, half) do { _Pragma("unroll") for (int i_ = 0; i_ < 4; ++i_) { \
        const f32x4 s4_ = *(const LAS f32x4*)(F.lds + (ci).sco + ((ci).k0 + 64 * (half) + 16 * i_ + 4 * kq) * 4); \
        _Pragma("unroll") for (int nn_ = 0; nn_ < 4; ++nn_) { const unsigned t_ = cvt4_fp8(srcv[i_][0][nn_] * s4_[0], srcv[i_][1][nn_] * s4_[1], srcv[i_][2][nn_] * s4_[2], srcv[i_][3][nn_] * s4_[3]); \
            const int n_ = 4 * nq + nn_, d_ = (4 * (4 * (half) + i_) + kq) ^ (4 * (nq & 7)); *(LAS unsigned*)(tile + n_ * 128 + d_ * 4) = t_; } } } while (0)
#define CONV_STORE(ci) do { asm volatile("s_waitcnt lgkmcnt(0)" ::: "memory"); \
        _Pragma("unroll") for (int r_ = 0; r_ < 8; ++r_) { const int n_ = (lane >> 3) + 8 * r_, c_ = lane & 7; const u32x4 o_ = *(const LAS u32x4*)(tile + n_ * 128 + 16 * (c_ ^ ((n_ >> 2) & 7))); \
            __builtin_nontemporal_store(o_, (u32x4*)((ci).WT + (size_t)((ci).drow0 + n_) * 2048 + (ci).k0 + 16 * c_)); } \
        asm volatile("s_waitcnt lgkmcnt(0)" ::: "memory"); } while (0)
__device__ __forceinline__ void moe_weight_convert(const Params& p, Frame& F, int gw, int NGW, int it0, int NIT) {
    LAS unsigned char* tile = F.lds + 16384 + F.wave * 8192;
    const int lane = F.lane, kq = lane >> 4, nq = lane & 15;
    __syncthreads();
    for (int i = F.tid; i < DM; i += 512) { *(LAS float*)(F.lds + 4 * i) = p.in[11][i] * 64.0f; *(LAS float*)(F.lds + 8192 + 4 * i) = 64.0f; }
    __syncthreads();
    int it = it0 + gw; if (it >= NIT) return;
    ConvItem cur = conv_item(p, it);
    f32x4 va[4][4], vb[4][4];
    CONV_LOAD(va, cur, 0);
    for (;;) {
        CONV_LOAD(vb, cur, 1);
        CONV_PACK(va, cur, 0);
        const int nit = it + NGW; const bool more = nit < NIT;
        const ConvItem nxt = conv_item(p, more ? nit : it);
        CONV_LOAD(va, nxt, 0);
        CONV_PACK(vb, cur, 1);
        CONV_STORE(cur);
        if (!more) break;
        cur = nxt; it = nit;
    }
}
#undef CONV_LOAD
#undef CONV_PACK
#undef CONV_STORE

template <int MODE>
__device__ __forceinline__ void skinny_f32(const float* X, int r0, int kbeg, const float* W, const float* lnw, bf16_t* XB, f32x16& acc, float& ssq, int lane) {
    const int m = lane & 31, kk = lane >> 5;
    const float* xr = X + (size_t)(r0 + m) * DM;
    ssq = 0.f;
    f32x4 a[4], lw[4], na[4], nlw[4]; float b[16], nb[16];
#define SK_LOAD(A_, LW_, B_, kb_) do { const int k0_ = (kb_) + 16 * kk; \
        _Pragma("unroll") for (int j_ = 0; j_ < 4; ++j_) { A_[j_] = *(const f32x4*)(xr + k0_ + 4 * j_); LW_[j_] = *(const f32x4*)(lnw + k0_ + 4 * j_); } \
        _Pragma("unroll") for (int j_ = 0; j_ < 16; ++j_) { if (MODE == 0) B_[j_] = (m < 8) ? W[(size_t)(k0_ + j_) * D_IN + NPROJ + m] : 0.f; else B_[j_] = W[(size_t)(k0_ + j_) * NEXP + m]; } } while (0)
    SK_LOAD(a, lw, b, kbeg);
#pragma unroll 1
    for (int kb = kbeg; kb < kbeg + 512; kb += 32) {
        const int k0 = kb + 16 * kk;
        if (kb + 32 < kbeg + 512) SK_LOAD(na, nlw, nb, kb + 32);
#pragma unroll
        for (int j = 0; j < 4; ++j) ssq += (a[j][0] * a[j][0] + a[j][1] * a[j][1]) + (a[j][2] * a[j][2] + a[j][3] * a[j][3]);
        if (MODE == 0) {
            u32x4 q0, q1;
            q0.x = cvt_pk_bf16(b[0] * lw[0][0], b[1] * lw[0][1]); q0.y = cvt_pk_bf16(b[2] * lw[0][2], b[3] * lw[0][3]); q0.z = cvt_pk_bf16(b[4] * lw[1][0], b[5] * lw[1][1]); q0.w = cvt_pk_bf16(b[6] * lw[1][2], b[7] * lw[1][3]);
            q1.x = cvt_pk_bf16(b[8] * lw[2][0], b[9] * lw[2][1]); q1.y = cvt_pk_bf16(b[10] * lw[2][2], b[11] * lw[2][3]); q1.z = cvt_pk_bf16(b[12] * lw[3][0], b[13] * lw[3][1]); q1.w = cvt_pk_bf16(b[14] * lw[3][2], b[15] * lw[3][3]);
            u32x4 w0, w1; w0.x = cvt_pk_bf16(a[0][0], a[0][1]); w0.y = cvt_pk_bf16(a[0][2], a[0][3]); w0.z = cvt_pk_bf16(a[1][0], a[1][1]); w0.w = cvt_pk_bf16(a[1][2], a[1][3]);
            w1.x = cvt_pk_bf16(a[2][0], a[2][1]); w1.y = cvt_pk_bf16(a[2][2], a[2][3]); w1.z = cvt_pk_bf16(a[3][0], a[3][1]); w1.w = cvt_pk_bf16(a[3][2], a[3][3]);
            bf16_t* o = XB + (size_t)(r0 + m) * DM + k0; *(u32x4*)o = w0; *(u32x4*)(o + 8) = w1;
            acc = __builtin_amdgcn_mfma_f32_32x32x16_bf16(__builtin_bit_cast(bf16x8, w0), __builtin_bit_cast(bf16x8, q0), acc, 0, 0, 0);
            acc = __builtin_amdgcn_mfma_f32_32x32x16_bf16(__builtin_bit_cast(bf16x8, w1), __builtin_bit_cast(bf16x8, q1), acc, 0, 0, 0);
        } else {
#pragma unroll
            for (int j = 0; j < 16; ++j) acc = __builtin_amdgcn_mfma_f32_32x32x2f32(a[j >> 2][j & 3], b[j] * lw[j >> 2][j & 3], acc, 0, 0, 0);
        }
#pragma unroll
        for (int j = 0; j < 4; ++j) { a[j] = na[j]; lw[j] = nlw[j]; }
#pragma unroll
        for (int j = 0; j < 16; ++j) b[j] = nb[j];
    }
#undef SK_LOAD
    ssq += __shfl_xor(ssq, 32);
}

__device__ __forceinline__ void p0_prologue(const Params& p, Frame& F) {
    unsigned char* ws = p.ws;
    {
        LAS float* part = (LAS float*)(F.lds);
        LAS float* ssqp = (LAS float*)(F.lds + 8192);
        const float* x = p.in[0]; const float* ln1 = p.in[1]; const float* win = p.in[2];
        bf16_t* xb = (bf16_t*)(ws + WS_XB);
        for (int blk = F.vcu; blk < T_TOK / 64; blk += F.G) {
            const int g = F.wave >> 2, ks = F.wave & 3, r0 = blk * 64 + g * 32;
            f32x16 acc;
#pragma unroll
            for (int i = 0; i < 16; ++i) acc[i] = 0.f;
            float ssq;
            skinny_f32<0>(x, r0, ks * 512, win, ln1, xb, acc, ssq, F.lane);
            const int n = F.lane & 31, hh = F.lane >> 5;
            if (n < 8) {
#pragma unroll
                for (int i = 0; i < 16; ++i) { const int row = (i & 3) + 8 * (i >> 2) + 4 * hh; part[((g * 4 + ks) * 32 + row) * 8 + n] = acc[i]; }
            }
            if (F.lane < 32) ssqp[(g * 4 + ks) * 32 + F.lane] = ssq;
            __syncthreads();
            if (F.tid < 64) {
                const int gg = F.tid >> 5, mm = F.tid & 31, t = blk * 64 + F.tid;
                float s = 0.f;
#pragma unroll
                for (int q = 0; q < 4; ++q) s += ssqp[(gg * 4 + q) * 32 + mm];
                const float rs = 1.0f / sqrtf(s * (1.0f / DM) + EPS);
                ((float*)(ws + WS_RSTD1))[t] = rs;
                float gt[8];
#pragma unroll
                for (int nn = 0; nn < 8; ++nn) { float v = 0.f;
#pragma unroll
                    for (int q = 0; q < 4; ++q) v += part[((gg * 4 + q) * 32 + mm) * 8 + nn];
                    gt[nn] = v * rs; }
                float* go = (float*)(ws + WS_GATES) + (size_t)t * 8;
                float bi[4], bf[4];
#pragma unroll
                for (int h = 0; h < 4; ++h) { bi[h] = p.in[7][h]; bf[h] = p.in[8][h]; }
                f32x4 o0, o1;
#pragma unroll
                for (int h = 0; h < 4; ++h) { o0[h] = gt[h] + bi[h]; const float f = gt[4 + h] + bf[h];
                    o1[h] = fminf(f, 0.f) - log1pf(__expf(-fabsf(f))); }
                *(f32x4*)go = o0; *(f32x4*)(go + 4) = o1;
            }
            __syncthreads();
        }
    }
    {
        LAS unsigned char* tile = F.lds + 16384 + F.wave * 16384;
        const int gw = F.vcu * 8 + F.wave, NGW = F.G * 8;
        constexpr int KB = DM / 128;
        constexpr int I_IN = KB * (NPROJ / 64), I_OUT = KB * (DM / 64);
        const float* ln1 = p.in[1];
        (void)I_OUT;
        for (int it = gw; it < I_IN; it += NGW) {
            const int nb = it % (NPROJ / 64), kb = it / (NPROJ / 64); p0_transpose_item_bf16(p.in[2], D_IN, kb * 128, nb * 64, (bf16_t*)(ws + WS_WIN), DM, nb * 64, ln1, tile, F.lane);
        }
    }
}
__device__ __forceinline__ void wout_transpose(const Params& p, Frame& F, int gw, int NGW) {
    LAS unsigned char* tile = F.lds + 16384 + F.wave * 16384;
    __syncthreads();
    for (int it = gw; it < (DM / 128) * (DM / 64); it += NGW) {
        const int nb = it % (DM / 64), kb = it / (DM / 64); p0_transpose_item_bf16(p.in[10], DM, kb * 128, nb * 64, (bf16_t*)(p.ws + WS_WOUT), DM, nb * 64, nullptr, tile, F.lane);
    }
    __syncthreads();
}

#define LBAR() do { asm volatile("s_waitcnt lgkmcnt(0)" ::: "memory"); __builtin_amdgcn_s_barrier(); asm volatile("" ::: "memory"); } while (0)
#define VLBAR() do { asm volatile("s_waitcnt vmcnt(0) lgkmcnt(0)" ::: "memory"); __builtin_amdgcn_s_barrier(); asm volatile("" ::: "memory"); } while (0)
template <int LPR>
__device__ __forceinline__ void dma_rows(LAS unsigned char* dst, const bf16_t* src, size_t gstride, int ninstr, int wave, int lane) {
    constexpr int RPI = 64 / LPR;
    asm volatile("" : "+v"(lane));
    for (int i = wave; i < ninstr; i += 8) { const int row = i * RPI + lane / LPR, c = lane % LPR;
        __builtin_amdgcn_global_load_lds((const unsigned*)(src + (size_t)row * gstride + c * 8), (LAS unsigned*)(dst + i * 1024), 16, 0, 0); }
}
__device__ __forceinline__ bf16x8 lds_frag(const LAS bf16_t* base, int row, int stride, int kofs) { return *(const LAS bf16x8*)(base + row * stride + kofs); }
__device__ __forceinline__ bf16_t f2bf(float v) { return (bf16_t)(cvt_pk_bf16(v, 0.f) & 0xffffu); }
__device__ __forceinline__ void hg_gate(float z, float lb, float& lf, float& kk) { const float f = lb + (1.0f - lb) * sigmoidf_(z); lf = __logf(f); kk = 1.0f - f; }

constexpr int TS = 136;
constexpr int TT = 72;

__device__ __forceinline__ void hg_local_phase(const Params& p, Frame& F) {
    unsigned char* ws = p.ws; const int tid = F.tid, lane = F.lane, w = F.wave;
    LAS bf16_t* KdT = (LAS bf16_t*)(F.lds + 65536); LAS bf16_t* VT = (LAS bf16_t*)(F.lds + 83968);
    LAS float* seg = (LAS float*)(F.lds + 102400);
#define HGL_ISSUE(it_, set_) do { const int sh_ = (it_) >> 7, c_ = (it_) & 127, b_ = sh_ >> 3, h_ = sh_ & 7; const bf16_t* pj_ = (const bf16_t*)(ws + WS_PROJ) + ((size_t)b_ * SEQ + (size_t)c_ * 64) * NPROJ; \
        dma_rows<16>(F.lds + (set_) * 32768, pj_ + C_HF + h_ * 128, NPROJ, 16, w, lane); dma_rows<16>(F.lds + (set_) * 32768 + 16384, pj_ + C_HI + h_ * 128, NPROJ, 16, w, lane); \
        nl0 = p.in[3][h_ * 128 + (tid & 127)]; nl1 = p.in[3][1024 + h_ * 128 + (tid & 127)]; } while (0)
    float nl0 = 0.f, nl1 = 0.f;
    LBAR();
    int item = F.vcu, set = 0;
    if (item < 2048) HGL_ISSUE(item, 0);
    asm volatile("s_waitcnt vmcnt(0)" ::: "memory");
    for (; item < 2048; item += F.G, set ^= 1) {
        const float l0 = nl0, l1 = nl1;
        LBAR();
        if (item + F.G < 2048) HGL_ISSUE(item + F.G, set ^ 1);
        const LAS bf16_t* ZR = (const LAS bf16_t*)(F.lds + set * 32768); const LAS bf16_t* VR = (const LAS bf16_t*)(F.lds + set * 32768 + 16384);
        const int k = tid & 127, tq = w >> 1;
        const float lb = 1.0f / (1.0f + __expf(l1 - l0));
        float cs[16], kk[16]; float run = 0.f;
#pragma unroll
        for (int j = 0; j < 16; ++j) { float lf; hg_gate(bf2f(ZR[(16 * tq + j) * 128 + k]), lb, lf, kk[j]); run += lf; cs[j] = run; }
        seg[tq * 128 + k] = run;
        { unsigned pk[8];
#pragma unroll
          for (int j = 0; j < 8; ++j) pk[j] = (unsigned)VR[(16 * tq + 2 * j) * 128 + k] | ((unsigned)VR[(16 * tq + 2 * j + 1) * 128 + k] << 16);
          *(LAS u32x4*)(VT + k * TT + 16 * tq) = (u32x4){pk[0], pk[1], pk[2], pk[3]}; *(LAS u32x4*)(VT + k * TT + 16 * tq + 8) = (u32x4){pk[4], pk[5], pk[6], pk[7]}; }
        LBAR();
        float off = 0.f, tot = 0.f;
#pragma unroll
        for (int q = 0; q < 4; ++q) { const float s = seg[q * 128 + k]; tot += s; if (q < tq) off += s; }
        { unsigned pk[8];
#pragma unroll
          for (int j = 0; j < 8; ++j) pk[j] = cvt_pk_bf16(kk[2 * j] * __expf(tot - (off + cs[2 * j])), kk[2 * j + 1] * __expf(tot - (off + cs[2 * j + 1])));
          *(LAS u32x4*)(KdT + k * TT + 16 * tq) = (u32x4){pk[0], pk[1], pk[2], pk[3]}; *(LAS u32x4*)(KdT + k * TT + 16 * tq + 8) = (u32x4){pk[4], pk[5], pk[6], pk[7]}; }
        const float dve = __expf(tot);
        LBAR();
        const int fr = lane & 15, fq = lane >> 4;
        bf16x8 bv[2];
#pragma unroll
        for (int ks = 0; ks < 2; ++ks) bv[ks] = lds_frag(VT, 16 * w + fr, TT, 32 * ks + 8 * fq);
        u32x2 o[8];
#pragma unroll
        for (int kb = 0; kb < 8; ++kb) { f32x4 acc = (f32x4){0.f, 0.f, 0.f, 0.f};
#pragma unroll
            for (int ks = 0; ks < 2; ++ks) acc = __builtin_amdgcn_mfma_f32_16x16x32_bf16(lds_frag(KdT, 16 * kb + fr, TT, 32 * ks + 8 * fq), bv[ks], acc, 0, 0, 0);
            o[kb].x = cvt_pk_bf16(acc[0], acc[1]); o[kb].y = cvt_pk_bf16(acc[2], acc[3]); }
        asm volatile("s_waitcnt vmcnt(0)" ::: "memory");
        bf16_t* dS = (bf16_t*)(ws + WS_DS) + ((size_t)((item >> 7) * 128 + 16 * w + fr) * 128 + (item & 127)) * 128 + 4 * fq;
#pragma unroll
        for (int kb = 0; kb < 8; ++kb) *(u32x2*)(dS + 16 * kb) = o[kb];
        if (tq == 0) ((float*)(ws + WS_DVEC))[(size_t)item * 128 + k] = dve;
    }
#undef HGL_ISSUE
}

__device__ __forceinline__ void ml_local_phase(const Params& p, Frame& F) {
    unsigned char* ws = p.ws; const int tid = F.tid, lane = F.lane, w = F.wave;
    LAS bf16_t* KT = (LAS bf16_t*)(F.lds + 100352); LAS bf16_t* VT = (LAS bf16_t*)(F.lds + 118784);
    LAS float* nred = (LAS float*)(F.lds + 155648);
    float nli = 0.f, nlf = 0.f;
#define MLL_ISSUE(it_, set_) do { const int sh_ = (it_) >> 7, c_ = (it_) & 127, b_ = sh_ >> 2, h_ = sh_ & 3; const size_t t0_ = (size_t)b_ * SEQ + (size_t)c_ * 64; const bf16_t* pj_ = (const bf16_t*)(ws + WS_PROJ) + t0_ * NPROJ; \
        dma_rows<16>(F.lds + (set_) * 50176, pj_ + C_MK + h_ * 128 - 3 * (size_t)NPROJ, NPROJ, 17, w, lane); dma_rows<32>(F.lds + (set_) * 50176 + 17408, pj_ + C_MV + h_ * 256, NPROJ, 32, w, lane); \
        const float* gt_ = (const float*)(ws + WS_GATES) + (t0_ + lane) * 8; nli = gt_[h_]; nlf = gt_[4 + h_]; \
        { const int ch_ = 512 + h_ * 128 + (tid & 127); ncw[0] = p.in[5][ch_]; ncw[1] = p.in[5][1024 + ch_]; ncw[2] = p.in[5][2048 + ch_]; ncw[3] = p.in[5][3072 + ch_]; ncw[4] = p.in[6][ch_]; } } while (0)
    float ncw[5] = {0.f, 0.f, 0.f, 0.f, 0.f};
    LBAR();
    int item = F.vcu, set = 0;
    if (item < 1024) MLL_ISSUE(item, 0);
    asm volatile("s_waitcnt vmcnt(0)" ::: "memory");
    for (; item < 1024; item += F.G, set ^= 1) {
        const int c = item & 127;
        const float li = nli, lf = nlf, w0 = ncw[0], w1 = ncw[1], w2 = ncw[2], w3 = ncw[3], cb = ncw[4];
        LBAR();
        if (item + F.G < 1024) MLL_ISSUE(item + F.G, set ^ 1);
        const LAS bf16_t* KR = (const LAS bf16_t*)(F.lds + set * 50176); const LAS bf16_t* VR = (const LAS bf16_t*)(F.lds + set * 50176 + 17408);
        float g = lf;
#pragma unroll
        for (int o = 1; o < 64; o <<= 1) { const float v = __shfl_up(g, o); if (lane >= o) g += v; }
        const float glast = __shfl(g, 63), lws = glast - g + li;
        float mx = lws;
#pragma unroll
        for (int o = 1; o < 64; o <<= 1) mx = fmaxf(mx, __shfl_xor(mx, o));
        const float wsl = __expf(lws - mx);
        { const int v = tid & 255, hf = tid >> 8; unsigned pk[16];
#pragma unroll
          for (int j = 0; j < 16; ++j) pk[j] = (unsigned)VR[(32 * hf + 2 * j) * 256 + v] | ((unsigned)VR[(32 * hf + 2 * j + 1) * 256 + v] << 16);
#pragma unroll
          for (int q = 0; q < 4; ++q) *(LAS u32x4*)(VT + v * TT + 32 * hf + 8 * q) = (u32x4){pk[4 * q], pk[4 * q + 1], pk[4 * q + 2], pk[4 * q + 3]}; }
        { const int d = tid & 127, tq = w >> 1;
          float r[19];
#pragma unroll
          for (int j = 0; j < 19; ++j) { const float v = bf2f(KR[(16 * tq + j) * 128 + d]); r[j] = (c == 0 && 16 * tq + j < 3) ? 0.f : v; }
          float kw[16]; float ns = 0.f;
#pragma unroll
          for (int j = 0; j < 16; ++j) { const float a = cb + w0 * r[j] + w1 * r[j + 1] + w2 * r[j + 2] + w3 * r[j + 3];
              const float wv = __uint_as_float(__builtin_amdgcn_readlane(__float_as_uint(wsl), 16 * tq + j)); kw[j] = a * sigmoidf_(a) * wv; ns += kw[j]; }
          unsigned pk[8];
#pragma unroll
          for (int j = 0; j < 8; ++j) pk[j] = cvt_pk_bf16(kw[2 * j], kw[2 * j + 1]);
          *(LAS u32x4*)(KT + d * TT + 16 * tq) = (u32x4){pk[0], pk[1], pk[2], pk[3]}; *(LAS u32x4*)(KT + d * TT + 16 * tq + 8) = (u32x4){pk[4], pk[5], pk[6], pk[7]};
          nred[tq * 128 + d] = ns; }
        LBAR();
        const float dnv = (tid < 128) ? (nred[tid] + nred[128 + tid]) + (nred[256 + tid] + nred[384 + tid]) : 0.f;
        const int fr = lane & 15, fq = lane >> 4;
        u32x2 o[2][8];
#pragma unroll
        for (int mb = 0; mb < 2; ++mb) {
            bf16x8 bv[2];
#pragma unroll
            for (int ks = 0; ks < 2; ++ks) bv[ks] = lds_frag(VT, 32 * w + 16 * mb + fr, TT, 32 * ks + 8 * fq);
#pragma unroll
            for (int db = 0; db < 8; ++db) { f32x4 acc = (f32x4){0.f, 0.f, 0.f, 0.f};
#pragma unroll
                for (int ks = 0; ks < 2; ++ks) acc = __builtin_amdgcn_mfma_f32_16x16x32_bf16(lds_frag(KT, 16 * db + fr, TT, 32 * ks + 8 * fq), bv[ks], acc, 0, 0, 0);
                o[mb][db].x = cvt_pk_bf16(acc[0], acc[1]); o[mb][db].y = cvt_pk_bf16(acc[2], acc[3]); }
        }
        asm volatile("s_waitcnt vmcnt(0)" ::: "memory");
#pragma unroll
        for (int mb = 0; mb < 2; ++mb) { bf16_t* dC = (bf16_t*)(ws + WS_DC) + ((size_t)((item >> 7) * 256 + 32 * w + 16 * mb + fr) * 128 + (item & 127)) * 128 + 4 * fq;
#pragma unroll
            for (int db = 0; db < 8; ++db) *(u32x2*)(dC + 16 * db) = o[mb][db]; }
        if (tid < 128) ((float*)(ws + WS_DN))[(size_t)item * 128 + tid] = dnv;
        if (tid == 0) { float* ms = (float*)(ws + WS_MSC) + (size_t)item * 4; ms[0] = glast; ms[1] = mx; }
    }
#undef MLL_ISSUE
}

__device__ __forceinline__ void p2_scan(const Params& p, Frame& F) {
    unsigned char* ws = p.ws;
    for (int gid = F.vcu * 512 + F.tid; gid < 131072; gid += F.G * 512) {
        if (gid < 65536) {
            const int sh = gid >> 12, rem = gid & 4095;
            const bf16_t* dS = (const bf16_t*)(ws + WS_DS) + (size_t)(sh * 128 + (rem >> 5)) * 16384 + (rem & 31) * 4;
            const float* dv = (const float*)(ws + WS_DVEC) + (size_t)sh * 128 * 128 + (rem & 31) * 4;
            bf16_t* so = (bf16_t*)(ws + WS_SST) + (size_t)sh * 128 * 16384 + rem * 4;
            f32x4 run = (f32x4){0.f, 0.f, 0.f, 0.f};
#pragma unroll 1
            for (int cb = 0; cb < NCHUNK; cb += 16) {
                u32x2 d[16]; f32x4 de[16];
#pragma unroll
                for (int j = 0; j < 16; ++j) { d[j] = *(const u32x2*)(dS + (size_t)(cb + j) * 128); de[j] = *(const f32x4*)(dv + (cb + j) * 128); }
#pragma unroll
                for (int j = 0; j < 16; ++j) {
                    u32x2 o; o.x = cvt_pk_bf16(run[0], run[1]); o.y = cvt_pk_bf16(run[2], run[3]);
                    *(u32x2*)(so + (size_t)(cb + j) * 16384) = o;
                    run = de[j] * run + (f32x4){bflo(d[j].x), bfhi(d[j].x), bflo(d[j].y), bfhi(d[j].y)};
                }
            }
        } else {
            const int g2 = gid - 65536, sh = g2 >> 13, rem = g2 & 8191;
            const bf16_t* dC = (const bf16_t*)(ws + WS_DC) + (size_t)(sh * 256 + (rem >> 5)) * 16384 + (rem & 31) * 4;
            const float* ms = (const float*)(ws + WS_MSC) + (size_t)sh * 128 * 4;
            bf16_t* co = (bf16_t*)(ws + WS_CST) + (size_t)sh * 128 * 32768 + rem * 4;
            const bool do_n = (rem < 32);
            const float* dn = (const float*)(ws + WS_DN) + (size_t)sh * 128 * 128 + (rem & 31) * 4;
            float* nst = (float*)(ws + WS_NST) + (size_t)sh * 128 * 128 + (rem & 31) * 4;
            float* mso = (float*)(ws + WS_MST) + (size_t)sh * 128;
            f32x4 run = (f32x4){0.f, 0.f, 0.f, 0.f}, nrun = (f32x4){0.f, 0.f, 0.f, 0.f}; float m = 0.f;
#pragma unroll 1
            for (int cb = 0; cb < NCHUNK; cb += 16) {
                u32x2 d[16]; float gl[16], ml[16]; f32x4 dnv[16];
#pragma unroll
                for (int j = 0; j < 16; ++j) { d[j] = *(const u32x2*)(dC + (size_t)(cb + j) * 128); gl[j] = ms[(cb + j) * 4]; ml[j] = ms[(cb + j) * 4 + 1]; }
#pragma unroll
                for (int j = 0; j < 16; ++j) dnv[j] = (f32x4){0.f, 0.f, 0.f, 0.f};
                if (do_n) {
#pragma unroll
                    for (int j = 0; j < 16; ++j) dnv[j] = *(const f32x4*)(dn + (cb + j) * 128);
                }
#pragma unroll
                for (int j = 0; j < 16; ++j) { const int c = cb + j;
                    const float mn = fmaxf(gl[j] + m, ml[j]), dec = __expf(gl[j] + m - mn), sl = __expf(ml[j] - mn);
                    u32x2 o; o.x = cvt_pk_bf16(run[0], run[1]); o.y = cvt_pk_bf16(run[2], run[3]);
                    *(u32x2*)(co + (size_t)c * 32768) = o;
                    if (do_n) { *(f32x4*)(nst + c * 128) = nrun; nrun = dec * nrun + sl * dnv[j]; if (rem == 0) mso[c] = m; }
                    run = dec * run + sl * (f32x4){bflo(d[j].x), bfhi(d[j].x), bflo(d[j].y), bfhi(d[j].y)}; m = mn;
                }
            }
        }
    }
}

__device__ __forceinline__ void hg_out_phase(const Params& p, Frame& F) {
    unsigned char* ws = p.ws; const int tid = F.tid, lane = F.lane, w = F.wave;
    LAS bf16_t* GR = (LAS bf16_t*)(F.lds + 98304); LAS bf16_t* VT = (LAS bf16_t*)(F.lds + 114688);
    LAS bf16_t* ATT = (LAS bf16_t*)(F.lds + 133120) + w * (16 * TT); LAS float* seg = (LAS float*)(F.lds + 151552); LAS float* ssqp = (LAS float*)(F.lds + 153600);
#define HGO_ISSUE_QZV(it_, set_) do { const int sh_ = (it_) >> 7, c_ = (it_) & 127, b_ = sh_ >> 3, h_ = sh_ & 7; const bf16_t* pj_ = (const bf16_t*)(ws + WS_PROJ) + ((size_t)b_ * SEQ + (size_t)c_ * 64) * NPROJ; \
        dma_rows<16>(F.lds + (set_) * 49152, pj_ + C_HQ + h_ * 128, NPROJ, 16, w, lane); dma_rows<16>(F.lds + (set_) * 49152 + 16384, pj_ + C_HF + h_ * 128, NPROJ, 16, w, lane); \
        dma_rows<16>(F.lds + (set_) * 49152 + 32768, pj_ + C_HI + h_ * 128, NPROJ, 16, w, lane); \
        nl0 = p.in[3][h_ * 128 + (tid & 127)]; nl1 = p.in[3][1024 + h_ * 128 + (tid & 127)]; \
        _Pragma("unroll") for (int nb_ = 0; nb_ < 4; ++nb_) nnw[nb_] = p.in[4][h_ * 128 + 16 * (4 * vh + nb_) + fr]; } while (0)
#define HGO_ISSUE_G(it_) do { const int sh_ = (it_) >> 7, c_ = (it_) & 127, b_ = sh_ >> 3, h_ = sh_ & 7; const bf16_t* pj_ = (const bf16_t*)(ws + WS_PROJ) + ((size_t)b_ * SEQ + (size_t)c_ * 64) * NPROJ; \
        dma_rows<16>((LAS unsigned char*)GR, pj_ + C_HG + h_ * 128, NPROJ, 16, w, lane); } while (0)
    const int fr = lane & 15, fq = lane >> 4, tb = w & 3, vh = w >> 2;
    float nl0 = 0.f, nl1 = 0.f, nnw[4] = {0.f, 0.f, 0.f, 0.f};
    LBAR();
    int item = F.vcu, set = 0;
    if (item < 2048) { HGO_ISSUE_QZV(item, 0); HGO_ISSUE_G(item); }
    asm volatile("s_waitcnt vmcnt(0)" ::: "memory");
    for (; item < 2048; item += F.G, set ^= 1) {
        const int sh = item >> 7, c = item & 127, b = sh >> 3, h = sh & 7; const size_t t0 = (size_t)b * SEQ + (size_t)c * 64;
        const float l0 = nl0, l1 = nl1, nw0 = nnw[0], nw1 = nnw[1], nw2 = nnw[2], nw3 = nnw[3];
        LBAR();
        if (item + F.G < 2048) HGO_ISSUE_QZV(item + F.G, set ^ 1);
        LAS bf16_t* QR = (LAS bf16_t*)(F.lds + set * 49152); LAS bf16_t* ZR = QR + 8192; LAS bf16_t* VR = QR + 16384;
        bf16x8 stf[4][4];
        { const bf16_t* ST = (const bf16_t*)(ws + WS_SST) + (size_t)item * 16384;
#pragma unroll
          for (int nb = 0; nb < 4; ++nb)
#pragma unroll
              for (int ks = 0; ks < 4; ++ks) stf[nb][ks] = *(const bf16x8*)(ST + (size_t)(16 * (4 * vh + nb) + fr) * 128 + 32 * ks + 8 * fq); }
        __builtin_amdgcn_sched_barrier(0);
        const int k = tid & 127, tq = w >> 1;
        const float lb = 1.0f / (1.0f + __expf(l1 - l0));
        float cs[16], kk[16], rq[16]; float run = 0.f;
#pragma unroll
        for (int j = 0; j < 16; ++j) { float lf; hg_gate(bf2f(ZR[(16 * tq + j) * 128 + k]), lb, lf, kk[j]); run += lf; cs[j] = run; rq[j] = bf2f(QR[(16 * tq + j) * 128 + k]); }
        seg[tq * 128 + k] = run;
        { unsigned pk[8];
#pragma unroll
          for (int j = 0; j < 8; ++j) pk[j] = (unsigned)VR[(16 * tq + 2 * j) * 128 + k] | ((unsigned)VR[(16 * tq + 2 * j + 1) * 128 + k] << 16);
          *(LAS u32x4*)(VT + k * TT + 16 * tq) = (u32x4){pk[0], pk[1], pk[2], pk[3]}; *(LAS u32x4*)(VT + k * TT + 16 * tq + 8) = (u32x4){pk[4], pk[5], pk[6], pk[7]}; }
        LBAR();
        { float off = 0.f;
#pragma unroll
          for (int q = 0; q < 4; ++q) { const float s = seg[q * 128 + k]; if (q < tq) off += s; }
#pragma unroll
          for (int j = 0; j < 16; ++j) { const float bt = off + cs[j]; const int t = 16 * tq + j, sw = t * 128 + ((((k >> 3) ^ (t & 15)) << 3) | (k & 7));
              QR[sw] = f2bf(rq[j] * __expf(bt)); ZR[sw] = f2bf(kk[j] * __expf(-bt)); } }
        float gv[4][4];
#pragma unroll
        for (int i = 0; i < 4; ++i)
#pragma unroll
            for (int nb = 0; nb < 4; ++nb) gv[i][nb] = bf2f(GR[(16 * tb + 4 * fq + i) * 128 + 16 * (4 * vh + nb) + fr]);
        LBAR();
        if (item + F.G < 2048) HGO_ISSUE_G(item + F.G);
        bf16x8 aq[4];
#pragma unroll
        for (int ks = 0; ks < 4; ++ks) aq[ks] = *(const LAS bf16x8*)(QR + (16 * tb + fr) * 128 + (((4 * ks + fq) ^ fr) << 3));
#pragma unroll
        for (int sb = 0; sb < 4; ++sb) {
            f32x4 acc = (f32x4){0.f, 0.f, 0.f, 0.f};
            if (sb <= tb) {
#pragma unroll
                for (int ks = 0; ks < 4; ++ks) acc = __builtin_amdgcn_mfma_f32_16x16x32_bf16(aq[ks], *(const LAS bf16x8*)(ZR + (16 * sb + fr) * 128 + (((4 * ks + fq) ^ fr) << 3)), acc, 0, 0, 0);
            }
#pragma unroll
            for (int i = 0; i < 4; ++i) { const int tl = 16 * tb + 4 * fq + i, s = 16 * sb + fr; ATT[(4 * fq + i) * TT + s] = f2bf((s <= tl) ? acc[i] : 0.f); }
        }
        f32x4 o[4];
#pragma unroll
        for (int nb = 0; nb < 4; ++nb) { o[nb] = (f32x4){0.f, 0.f, 0.f, 0.f};
#pragma unroll
            for (int ks = 0; ks < 4; ++ks) o[nb] = __builtin_amdgcn_mfma_f32_16x16x32_bf16(aq[ks], stf[nb][ks], o[nb], 0, 0, 0); }
        asm volatile("s_waitcnt lgkmcnt(0)" ::: "memory");
        bf16x8 aa[2];
#pragma unroll
        for (int ks = 0; ks < 2; ++ks) aa[ks] = lds_frag(ATT, fr, TT, 32 * ks + 8 * fq);
#pragma unroll
        for (int nb = 0; nb < 4; ++nb) { const int vrow = 16 * (4 * vh + nb) + fr;
#pragma unroll
            for (int ks = 0; ks < 2; ++ks) o[nb] = __builtin_amdgcn_mfma_f32_16x16x32_bf16(aa[ks], lds_frag(VT, vrow, TT, 32 * ks + 8 * fq), o[nb], 0, 0, 0); }
        float sq[4];
#pragma unroll
        for (int i = 0; i < 4; ++i) { float s = 0.f;
#pragma unroll
            for (int nb = 0; nb < 4; ++nb) s += o[nb][i] * o[nb][i];
            s += __shfl_xor(s, 1); s += __shfl_xor(s, 2); s += __shfl_xor(s, 4); s += __shfl_xor(s, 8); sq[i] = s; }
        if (fr == 0) {
#pragma unroll
            for (int i = 0; i < 4; ++i) ssqp[vh * 64 + 16 * tb + 4 * fq + i] = sq[i]; }
        LBAR();
        const float nwv[4] = {nw0, nw1, nw2, nw3};
#pragma unroll
        for (int i = 0; i < 4; ++i) { const int tl = 16 * tb + 4 * fq + i; const float r = 1.0f / sqrtf((ssqp[tl] + ssqp[64 + tl]) * (1.0f / 128.0f) + EPS);
#pragma unroll
            for (int nb = 0; nb < 4; ++nb) { const int v = 16 * (4 * vh + nb) + fr; const float g = gv[i][nb];
                VR[tl * 128 + v] = f2bf(o[nb][i] * r * nwv[nb] * (g * sigmoidf_(g))); } }
        LBAR();
        u32x4 ov[2];
#pragma unroll
        for (int q = 0; q < 2; ++q) { const int cix = tid + 512 * q; ov[q] = *(const LAS u32x4*)(VR + (cix >> 4) * 128 + (cix & 15) * 8); }
        asm volatile("s_waitcnt vmcnt(0)" ::: "memory");
        bf16_t* mix = (bf16_t*)(ws + WS_MIX) + t0 * DM + h * 128;
#pragma unroll
        for (int q = 0; q < 2; ++q) { const int cix = tid + 512 * q; *(u32x4*)(mix + (size_t)(cix >> 4) * DM + (cix & 15) * 8) = ov[q]; }
    }
#undef HGO_ISSUE_QZV
#undef HGO_ISSUE_G
}

__device__ __forceinline__ void ml_out_phase(const Params& p, Frame& F) {
    unsigned char* ws = p.ws; const int tid = F.tid, lane = F.lane, w = F.wave;
    LAS bf16_t* QR = (LAS bf16_t*)(F.lds); LAS bf16_t* KR = (LAS bf16_t*)(F.lds + 17408); LAS bf16_t* VR = (LAS bf16_t*)(F.lds + 34816); LAS bf16_t* VT = (LAS bf16_t*)(F.lds + 67584);
    LAS bf16_t* ATT = (LAS bf16_t*)(F.lds + 104448) + w * (16 * TT);
    LAS float* avec = (LAS float*)(F.lds + 122880); LAS float* Mvec = avec + 64; LAS float* wint = avec + 128; LAS float* eneg = avec + 192; LAS float* ssqp = avec + 256; LAS float* qnl = avec + 384;
    float nli = 0.f, nlf = 0.f, nmst = 0.f;
#define MLO_ISSUE_QK(it_) do { const int sh_ = (it_) >> 7, c_ = (it_) & 127, b_ = sh_ >> 2, h_ = sh_ & 3; const size_t t0_ = (size_t)b_ * SEQ + (size_t)c_ * 64; const bf16_t* pj_ = (const bf16_t*)(ws + WS_PROJ) + t0_ * NPROJ; \
        dma_rows<16>((LAS unsigned char*)QR, pj_ + C_MQ + h_ * 128 - 3 * (size_t)NPROJ, NPROJ, 17, w, lane); dma_rows<16>((LAS unsigned char*)KR, pj_ + C_MK + h_ * 128 - 3 * (size_t)NPROJ, NPROJ, 17, w, lane); \
        const float* gt_ = (const float*)(ws + WS_GATES) + (t0_ + lane) * 8; nli = gt_[h_]; nlf = gt_[4 + h_]; nmst = ((const float*)(ws + WS_MST))[(it_)]; \
        { const int cq_ = h_ * 128 + (tid & 127), ck_ = 512 + cq_; _Pragma("unroll") for (int j_ = 0; j_ < 4; ++j_) { ncw[j_] = p.in[5][1024 * j_ + cq_]; ncw[5 + j_] = p.in[5][1024 * j_ + ck_]; } ncw[4] = p.in[6][cq_]; ncw[9] = p.in[6][ck_]; } \
        nnw = p.in[9][h_ * 256 + (tid & 255)]; } while (0)
#define MLO_ISSUE_V(it_, col_) do { const int sh_ = (it_) >> 7, c_ = (it_) & 127, b_ = sh_ >> 2, h_ = sh_ & 3; const bf16_t* pj_ = (const bf16_t*)(ws + WS_PROJ) + ((size_t)b_ * SEQ + (size_t)c_ * 64) * NPROJ; \
        dma_rows<32>((LAS unsigned char*)VR, pj_ + (col_) + h_ * 256, NPROJ, 32, w, lane); } while (0)
    const int fr = lane & 15, fq = lane >> 4, tb = w & 3, vh = w >> 2;
    float ncw[10], nnw = 0.f;
    LAS float* nwl = avec + 512;
#pragma unroll
    for (int j = 0; j < 10; ++j) ncw[j] = 0.f;
    LBAR();
    int item = F.vcu;
    if (item < 1024) { MLO_ISSUE_QK(item); MLO_ISSUE_V(item, C_MV); }
    for (; item < 1024; item += F.G) {
        const int sh = item >> 7, c = item & 127, b = sh >> 2, h = sh & 3; const size_t t0 = (size_t)b * SEQ + (size_t)c * 64;
        const float li = nli, lf = nlf, mst = nmst;
        float cwv[10];
#pragma unroll
        for (int j = 0; j < 10; ++j) cwv[j] = ncw[j];
        const float nwx = nnw;
        VLBAR();
        if (tid < 256) nwl[tid] = nwx;
        f32x4 nsv[8]; bf16x8 ctf[4][4], ctg[4][4];
        { const bf16_t* CT = (const bf16_t*)(ws + WS_CST) + (size_t)item * 32768;
#pragma unroll
          for (int nb = 0; nb < 4; ++nb)
#pragma unroll
              for (int ks = 0; ks < 4; ++ks) ctf[nb][ks] = *(const bf16x8*)(CT + (size_t)(16 * (8 * vh + nb) + fr) * 128 + 32 * ks + 8 * fq); }
        __builtin_amdgcn_sched_barrier(0);
        if (w == 0) {
            float g = lf;
#pragma unroll
            for (int o = 1; o < 64; o <<= 1) { const float v = __shfl_up(g, o); if (lane >= o) g += v; }
            const float a = li - g; float pm = a;
#pragma unroll
            for (int o = 1; o < 64; o <<= 1) { const float v = __shfl_up(pm, o); if (lane >= o) pm = fmaxf(pm, v); }
            const float M = fmaxf(mst, pm);
            int ln = lane; asm volatile("" : "+v"(ln)); LAS float* gs = avec + ln;
            gs[0] = a; gs[64] = M; gs[128] = __expf(mst - M); gs[192] = __expf(-(g + M));
        }
        { const int v = tid & 255, hf = tid >> 8; unsigned pk[16];
#pragma unroll
          for (int j = 0; j < 16; ++j) pk[j] = (unsigned)VR[(32 * hf + 2 * j) * 256 + v] | ((unsigned)VR[(32 * hf + 2 * j + 1) * 256 + v] << 16);
#pragma unroll
          for (int q = 0; q < 4; ++q) *(LAS u32x4*)(VT + v * TT + 32 * hf + 8 * q) = (u32x4){pk[4 * q], pk[4 * q + 1], pk[4 * q + 2], pk[4 * q + 3]}; }
        const int d = tid & 127, tq = w >> 1;
        float rq[19], rk[19];
#pragma unroll
        for (int j = 0; j < 19; ++j) { const bool z = (c == 0 && 16 * tq + j < 3); const float a = bf2f(QR[(16 * tq + j) * 128 + d]), bb = bf2f(KR[(16 * tq + j) * 128 + d]); rq[j] = z ? 0.f : a; rk[j] = z ? 0.f : bb; }
        LBAR();
        MLO_ISSUE_V(item, C_MO);
        { const float q0 = cwv[0], q1 = cwv[1], q2 = cwv[2], q3 = cwv[3], qb = cwv[4], k0 = cwv[5], k1 = cwv[6], k2 = cwv[7], k3 = cwv[8], kb = cwv[9];
#pragma unroll
          for (int j = 0; j < 16; ++j) { const float a = qb + q0 * rq[j] + q1 * rq[j + 1] + q2 * rq[j + 2] + q3 * rq[j + 3]; const float bq = kb + k0 * rk[j] + k1 * rk[j + 1] + k2 * rk[j + 2] + k3 * rk[j + 3];
              const int t = 16 * tq + j, sw = t * 128 + ((((d >> 3) ^ (t & 15)) << 3) | (d & 7));
              QR[sw] = f2bf(a * sigmoidf_(a) * 0.08838834764831845f); KR[sw] = f2bf(bq * sigmoidf_(bq)); } }
        LBAR();
        { const float* nst = (const float*)(ws + WS_NST) + (size_t)item * 128;
#pragma unroll
          for (int ks = 0; ks < 4; ++ks) { nsv[2 * ks] = *(const f32x4*)(nst + 32 * ks + 8 * fq); nsv[2 * ks + 1] = *(const f32x4*)(nst + 32 * ks + 8 * fq + 4); } }
        __builtin_amdgcn_sched_barrier(0);
        bf16x8 aq[4];
#pragma unroll
        for (int ks = 0; ks < 4; ++ks) aq[ks] = *(const LAS bf16x8*)(QR + (16 * tb + fr) * 128 + (((4 * ks + fq) ^ fr) << 3));
        float Mr[4], wi[4], rsum[4];
#pragma unroll
        for (int i = 0; i < 4; ++i) { const int tl = 16 * tb + 4 * fq + i; Mr[i] = Mvec[tl]; wi[i] = wint[tl]; rsum[i] = 0.f; }
#pragma unroll
        for (int sb = 0; sb < 4; ++sb) {
            f32x4 acc = (f32x4){0.f, 0.f, 0.f, 0.f};
            if (sb <= tb) {
#pragma unroll
                for (int ks = 0; ks < 4; ++ks) acc = __builtin_amdgcn_mfma_f32_16x16x32_bf16(aq[ks], *(const LAS bf16x8*)(KR + (16 * sb + fr) * 128 + (((4 * ks + fq) ^ fr) << 3)), acc, 0, 0, 0);
            }
            const int s = 16 * sb + fr; const float as = avec[s];
#pragma unroll
            for (int i = 0; i < 4; ++i) { const int tl = 16 * tb + 4 * fq + i; const float v = (s <= tl) ? acc[i] * __expf(as - Mr[i]) : 0.f; rsum[i] += v; ATT[(4 * fq + i) * TT + s] = f2bf(v); }
        }
#pragma unroll
        for (int i = 0; i < 4; ++i) { float s = rsum[i]; s += __shfl_xor(s, 1); s += __shfl_xor(s, 2); s += __shfl_xor(s, 4); s += __shfl_xor(s, 8); rsum[i] = s; }
        f32x4 o[8];
#pragma unroll
        for (int nb = 0; nb < 4; ++nb) { o[nb] = (f32x4){0.f, 0.f, 0.f, 0.f};
#pragma unroll
            for (int ks = 0; ks < 4; ++ks) o[nb] = __builtin_amdgcn_mfma_f32_16x16x32_bf16(aq[ks], ctf[nb][ks], o[nb], 0, 0, 0);
#pragma unroll
            for (int i = 0; i < 4; ++i) o[nb][i] *= wi[i]; }
        { float s = 0.f;
#pragma unroll
          for (int ks = 0; ks < 4; ++ks) { const f32x4 n0 = nsv[2 * ks], n1 = nsv[2 * ks + 1];
              const unsigned* aw = (const unsigned*)&aq[ks];
              s += bflo(aw[0]) * n0[0] + bfhi(aw[0]) * n0[1] + bflo(aw[1]) * n0[2] + bfhi(aw[1]) * n0[3] + bflo(aw[2]) * n1[0] + bfhi(aw[2]) * n1[1] + bflo(aw[3]) * n1[2] + bfhi(aw[3]) * n1[3]; }
          s += __shfl_xor(s, 16); s += __shfl_xor(s, 32);
          if (fq == 0) qnl[w * 16 + fr] = s; }
        __builtin_amdgcn_sched_barrier(0);
        { const bf16_t* CT = (const bf16_t*)(ws + WS_CST) + (size_t)item * 32768;
#pragma unroll
          for (int nb = 0; nb < 4; ++nb)
#pragma unroll
              for (int ks = 0; ks < 4; ++ks) ctg[nb][ks] = *(const bf16x8*)(CT + (size_t)(16 * (8 * vh + 4 + nb) + fr) * 128 + 32 * ks + 8 * fq); }
        __builtin_amdgcn_sched_barrier(0);
        asm volatile("s_waitcnt lgkmcnt(0)" ::: "memory");
        bf16x8 aa[2];
#pragma unroll
        for (int ks = 0; ks < 2; ++ks) aa[ks] = lds_frag(ATT, fr, TT, 32 * ks + 8 * fq);
#pragma unroll
        for (int nb = 0; nb < 4; ++nb) { const int vrow = 16 * (8 * vh + nb) + fr;
#pragma unroll
            for (int ks = 0; ks < 2; ++ks) o[nb] = __builtin_amdgcn_mfma_f32_16x16x32_bf16(aa[ks], lds_frag(VT, vrow, TT, 32 * ks + 8 * fq), o[nb], 0, 0, 0); }
        __builtin_amdgcn_sched_barrier(0);
#pragma unroll
        for (int nb = 4; nb < 8; ++nb) { o[nb] = (f32x4){0.f, 0.f, 0.f, 0.f};
#pragma unroll
            for (int ks = 0; ks < 4; ++ks) o[nb] = __builtin_amdgcn_mfma_f32_16x16x32_bf16(aq[ks], ctg[nb - 4][ks], o[nb], 0, 0, 0);
#pragma unroll
            for (int i = 0; i < 4; ++i) o[nb][i] *= wi[i];
            const int vrow = 16 * (8 * vh + nb) + fr;
#pragma unroll
            for (int ks = 0; ks < 2; ++ks) o[nb] = __builtin_amdgcn_mfma_f32_16x16x32_bf16(aa[ks], lds_frag(VT, vrow, TT, 32 * ks + 8 * fq), o[nb], 0, 0, 0); }
        float sq[4];
#pragma unroll
        for (int i = 0; i < 4; ++i) { const int tl = 16 * tb + 4 * fq + i; const float den = wi[i] * qnl[w * 16 + 4 * fq + i] + rsum[i]; const float inv = 1.0f / fmaxf(fabsf(den), eneg[tl]);
            float s = 0.f;
#pragma unroll
            for (int nb = 0; nb < 8; ++nb) { o[nb][i] *= inv; s += o[nb][i] * o[nb][i]; }
            s += __shfl_xor(s, 1); s += __shfl_xor(s, 2); s += __shfl_xor(s, 4); s += __shfl_xor(s, 8); sq[i] = s; }
        if (fr == 0) {
#pragma unroll
            for (int i = 0; i < 4; ++i) ssqp[vh * 64 + 16 * tb + 4 * fq + i] = sq[i]; }
        VLBAR();
        if (item + F.G < 1024) MLO_ISSUE_QK(item + F.G);
#pragma unroll
        for (int i = 0; i < 4; ++i) { const int tl = 16 * tb + 4 * fq + i; const float r = 1.0f / sqrtf((ssqp[tl] + ssqp[64 + tl]) * (1.0f / 256.0f) + EPS);
#pragma unroll
            for (int nb = 0; nb < 8; ++nb) { const int v = 16 * (8 * vh + nb) + fr; const float g = bf2f(VR[tl * 256 + v]);
                VR[tl * 256 + v] = f2bf(o[nb][i] * r * nwl[v] * sigmoidf_(g)); } }
        LBAR();
        bf16_t* mix = (bf16_t*)(ws + WS_MIX) + t0 * DM + 1024 + h * 256;
        for (int cix = tid; cix < 2048; cix += 512) { const int r = cix >> 5, cc = cix & 31; *(u32x4*)(mix + (size_t)r * DM + cc * 8) = *(const LAS u32x4*)(VR + r * 256 + cc * 8); }
        LBAR();
        if (item + F.G < 1024) MLO_ISSUE_V(item + F.G, C_MV);
    }
#undef MLO_ISSUE_QK
#undef MLO_ISSUE_V
}

__device__ __forceinline__ void p4_router(const Params& p, Frame& F) {
    unsigned char* ws = p.ws;
    LAS float* part = (LAS float*)(F.lds);
    LAS float* ssqp = (LAS float*)(F.lds + 32768);
    LAS int* hist = (LAS int*)(F.lds + L_HIST); LAS int* gbase = hist + 32;
    const float* x1 = (const float*)(ws + WS_X1);
    unsigned* gcnt = (unsigned*)(ws + WS_CTL) + CW_CNT;
    for (int blk = F.vcu; blk < T_TOK / 64; blk += F.G) {
        const int g = F.wave >> 2, ks = F.wave & 3, r0 = blk * 64 + g * 32;
        f32x16 acc;
#pragma unroll
        for (int i = 0; i < 16; ++i) acc[i] = 0.f;
        float ssq;
        skinny_f32<1>(x1, r0, ks * 512, p.in[12], p.in[11], nullptr, acc, ssq, F.lane);
        const int n = F.lane & 31, hh = F.lane >> 5;
#pragma unroll
        for (int i = 0; i < 16; ++i) { const int row = (i & 3) + 8 * (i >> 2) + 4 * hh; part[((g * 4 + ks) * 32 + row) * 32 + n] = acc[i]; }
        if (F.lane < 32) ssqp[(g * 4 + ks) * 32 + F.lane] = ssq;
        if (F.tid < 32) hist[F.tid] = 0;
        __syncthreads();
        int es[4] = {0, 0, 0, 0}, lp[4] = {0, 0, 0, 0}; float gv[4] = {0.f, 0.f, 0.f, 0.f}; float rs = 0.f; const int t = blk * 64 + F.tid;
        if (F.tid < 64) {
            const int gg = F.tid >> 5, mm = F.tid & 31;
            float s = 0.f;
#pragma unroll
            for (int q = 0; q < 4; ++q) s += ssqp[(gg * 4 + q) * 32 + mm];
            rs = 1.0f / sqrtf(s * (1.0f / DM) + EPS);
            float lg[32];
#pragma unroll
            for (int e = 0; e < 32; ++e) { float v = 0.f;
#pragma unroll
                for (int q = 0; q < 4; ++q) v += part[((gg * 4 + q) * 32 + mm) * 32 + e];
                lg[e] = v * rs + p.in[13][e]; }
            unsigned used = 0u; float tv[4];
#pragma unroll
            for (int j = 0; j < 4; ++j) { float best = -3.0e38f; int bi = 0;
#pragma unroll
                for (int e = 0; e < 32; ++e) { const bool ok = !((used >> e) & 1u) && (lg[e] > best); best = ok ? lg[e] : best; bi = ok ? e : bi; }
                used |= 1u << bi; es[j] = bi; tv[j] = best; }
            float den = 0.f;
#pragma unroll
            for (int j = 0; j < 4; ++j) { gv[j] = __expf(tv[j] - tv[0]); den += gv[j]; }
            const float inv = 1.0f / den;
#pragma unroll
            for (int j = 0; j < 4; ++j) { gv[j] *= inv; lp[j] = __hip_atomic_fetch_add(&hist[es[j]], 1, __ATOMIC_RELAXED, __HIP_MEMORY_SCOPE_WORKGROUP); }
        }
        __syncthreads();
        if (F.tid < 32) { const int cnt = hist[F.tid]; gbase[F.tid] = cnt ? (int)atomicAdd(&gcnt[F.tid], (unsigned)cnt) : 0; }
        __syncthreads();
        if (F.tid < 64) {
            ((float*)(ws + WS_RSTD2))[t] = rs;
#pragma unroll
            for (int j = 0; j < 4; ++j) { const int e = es[j], pos = gbase[e] + lp[j];
                ((int*)(ws + WS_LTOK))[e * LIST_STRIDE + pos] = t; ((float*)(ws + WS_LRS))[e * LIST_STRIDE + pos] = rs;
                ((int*)(ws + WS_TOKE))[t * 4 + j] = e; ((int*)(ws + WS_TOKP))[t * 4 + j] = pos; ((float*)(ws + WS_TOKG))[t * 4 + j] = gv[j]; }
        }
        __syncthreads();
    }
}
__device__ __forceinline__ void moe_tables(const Params& p, Frame& F) {
    LAS int* tile0 = (LAS int*)(F.lds + L_TILE0); LAS int* cnt = (LAS int*)(F.lds + L_CNT);
    if (F.tid < 64) {
        const unsigned* gcnt = (const unsigned*)(p.ws + WS_CTL) + CW_CNT; const int e = F.tid & 31;
        const int c = (int)__hip_atomic_load(gcnt + e, __ATOMIC_RELAXED, __HIP_MEMORY_SCOPE_AGENT); const int nt = (c + 255) >> 8;
        int inc = nt;
#pragma unroll
        for (int o = 1; o < 32; o <<= 1) { const int v = __shfl_up(inc, o, 32); if (e >= o) inc += v; }
        if (F.tid < 32) { cnt[e] = c; tile0[e] = inc - nt; if (e == NEXP - 1) tile0[NEXP] = inc; }
    }
    __syncthreads();
}

__device__ __forceinline__ void p7_final(const Params& p, Frame& F) {
    unsigned char* ws = p.ws; const LAS int* tile0 = (const LAS int*)(F.lds + L_TILE0);
    const float* x1 = (const float*)(ws + WS_X1); const unsigned char* ys = (const unsigned char*)(ws + WS_YS); const float* fw = p.in[20];
    const int gw = F.vcu * 8 + F.wave, NGW = F.G * 8, lane = F.lane;
    LAS float* fwl = (LAS float*)(F.lds + 16384);
    for (int i = F.tid; i < DM; i += 512) fwl[i] = fw[i];
    __syncthreads();
    if (gw >= T_TOK) return;
    f32x4 v[8], nv[8]; i32x4 me, mp, nme, nmp; f32x4 mg, nmg;
#define P7_LOAD(V_, E_, P_, G_, t_) do { E_ = *(const i32x4*)((const int*)(ws + WS_TOKE) + (t_) * 4); P_ = *(const i32x4*)((const int*)(ws + WS_TOKP) + (t_) * 4); G_ = *(const f32x4*)((const float*)(ws + WS_TOKG) + (t_) * 4); \
        _Pragma("unroll") for (int i_ = 0; i_ < 4; ++i_) { V_[2 * i_] = *(const f32x4*)(x1 + (size_t)(t_) * DM + 512 * i_ + 8 * lane); V_[2 * i_ + 1] = *(const f32x4*)(x1 + (size_t)(t_) * DM + 512 * i_ + 8 * lane + 4); } } while (0)
    P7_LOAD(v, me, mp, mg, gw);
    for (int t = gw; t < T_TOK; t += NGW) {
        u32x2 y[4][4];
#pragma unroll
        for (int j = 0; j < 4; ++j) { const size_t slot = (size_t)tile0[me[j]] * 256 + mp[j];
#pragma unroll
            for (int i = 0; i < 4; ++i) y[j][i] = *(const u32x2*)(ys + slot * DM + 512 * i + 8 * lane); }
        const int tn = (t + NGW < T_TOK) ? t + NGW : t;
        P7_LOAD(nv, nme, nmp, nmg, tn);
#pragma unroll
        for (int j = 0; j < 4; ++j) { const float g = mg[j]; __builtin_amdgcn_sched_barrier(0);
#pragma unroll
            for (int i = 0; i < 4; ++i) {
                const f32x2_t a0 = __builtin_amdgcn_cvt_pk_f32_fp8(y[j][i].x, false), a1 = __builtin_amdgcn_cvt_pk_f32_fp8(y[j][i].x, true), a2 = __builtin_amdgcn_cvt_pk_f32_fp8(y[j][i].y, false), a3 = __builtin_amdgcn_cvt_pk_f32_fp8(y[j][i].y, true);
                v[2 * i][0] += g * a0.x; v[2 * i][1] += g * a0.y; v[2 * i][2] += g * a1.x; v[2 * i][3] += g * a1.y;
                v[2 * i + 1][0] += g * a2.x; v[2 * i + 1][1] += g * a2.y; v[2 * i + 1][2] += g * a3.x; v[2 * i + 1][3] += g * a3.y; } }
        float s = 0.f;
#pragma unroll
        for (int i = 0; i < 8; ++i) s += (v[i][0] * v[i][0] + v[i][1] * v[i][1]) + (v[i][2] * v[i][2] + v[i][3] * v[i][3]);
        const float rs = 1.0f / sqrtf(wave_sum(s) * (1.0f / DM) + EPS);
        int fo = 8 * lane; asm volatile("" : "+v"(fo));
#pragma unroll
        for (int i = 0; i < 4; ++i) {
            const f32x4 w0 = *(const LAS f32x4*)(fwl + 512 * i + fo), w1 = *(const LAS f32x4*)(fwl + 512 * i + fo + 4);
            *(f32x4*)(p.out + (size_t)t * DM + 512 * i + 8 * lane) = v[2 * i] * rs * w0; *(f32x4*)(p.out + (size_t)t * DM + 512 * i + 8 * lane + 4) = v[2 * i + 1] * rs * w1; }
#pragma unroll
        for (int i = 0; i < 8; ++i) v[i] = nv[i];
        me = nme; mp = nmp; mg = nmg;
    }
#undef P7_LOAD
}

#ifndef NG_GEMM
#define NG_GEMM 180
#endif
#ifndef NG_MOE1
#define NG_MOE1 232
#endif
constexpr int CONV_N_GU = NEXP * 2 * (DM / 128) * (DFF / 64), CONV_N_ALL = NEXP * 3 * (DM / 128) * (DFF / 64);
constexpr int N_PHASES = 10;
__global__ void __launch_bounds__(512, 2) hymba_fwd(Params p) {
    extern __shared__ __attribute__((aligned(16))) unsigned char lds_raw[];
    Frame F; F.lds = (LAS unsigned char*)lds_raw; F.tid = threadIdx.x; F.lane = F.tid & 63; F.wave = __builtin_amdgcn_readfirstlane(F.tid >> 6);
    F.G = gridDim.x; { const int bx = blockIdx.x; F.vcu = (F.G % 8 == 0) ? (bx % 8) * (F.G / 8) + bx / 8 : bx; }
    for (int u = F.tid; u < (LDS_BYTES - LDSCTL_OFF) / 4; u += 512) ((LAS unsigned*)(F.lds + LDSCTL_OFF))[u] = 0u;
    __syncthreads();
    unsigned char* ws = p.ws;
    unsigned* ctl = (unsigned*)(ws + WS_CTL);
    XcdBarrier bar; bar.bar = ctl + CW_BAR + p.li * XCD_BAR_WORDS; bar.x = 0; bar.st = nullptr;
    const int lo = p.ph_lo, hi = p.ph_hi;
    if (hi - lo > 1) bar = xcd_barrier_post(ctl + CW_BAR + p.li * XCD_BAR_WORDS, (volatile LAS unsigned*)(F.lds + L_MISC) + 8);
#define IN(k) (lo <= (k) && (k) < hi)
#define SEAM(k) do { if (IN(k) && IN((k) + 1)) xcd_barrier(bar); } while (0)
    LAS unsigned char* ring = F.lds;

    if (IN(0)) { p0_prologue(p, F); }
    SEAM(0);
    if (IN(1)) {
        const int ng = (F.G == 256) ? NG_GEMM : F.G;
        if ((int)blockIdx.x < ng) {
            pg8::Gemm g{(const bf16_t*)(ws + WS_XB), (const bf16_t*)(ws + WS_WIN), DM}; pg8::StaticOrder S; S.init(T_TOK, NPROJ, ng, (int)blockIdx.x);
            EpiProj E{(bf16_t*)(ws + WS_PROJ), (const float*)(ws + WS_RSTD1)};
            pg8::gemm_phase<EpiProj, pg8::StaticOrder, false, false, true, false>(ring, g, S, E);
            if (ng == F.G) { wout_transpose(p, F, (int)blockIdx.x * 8 + F.wave, F.G * 8); moe_weight_convert(p, F, (int)blockIdx.x * 8 + F.wave, F.G * 8, 0, CONV_N_GU); }
        } else { wout_transpose(p, F, ((int)blockIdx.x - ng) * 8 + F.wave, (F.G - ng) * 8); moe_weight_convert(p, F, ((int)blockIdx.x - ng) * 8 + F.wave, (F.G - ng) * 8, 0, CONV_N_GU); }
    }
    SEAM(1);
    if (IN(2)) {
        hg_local_phase(p, F); ml_local_phase(p, F);
    }
    SEAM(2);
    if (IN(3)) { p2_scan(p, F); }
    SEAM(3);
    if (IN(4)) {
        hg_out_phase(p, F); ml_out_phase(p, F);
    }
    SEAM(4);
    if (IN(5)) {
        pg8::Gemm g{(const bf16_t*)(ws + WS_MIX), (const bf16_t*)(ws + WS_WOUT), DM}; pg8::StaticOrder S; S.init(T_TOK, DM, F.G, (int)blockIdx.x);
        EpiOut E{p.in[0], (float*)(ws + WS_X1), (unsigned char*)(ws + WS_X1B)};
        pg8::gemm_phase<EpiOut, pg8::StaticOrder, false, false, true, false>(ring, g, S, E);
    }
    SEAM(5);
    if (IN(6)) { p4_router(p, F); }
    SEAM(6);
    if (IN(7)) {
        const int ngm = (F.G == 256) ? NG_MOE1 : F.G;
        if (ngm == F.G) { moe_weight_convert(p, F, (int)blockIdx.x * 8 + F.wave, F.G * 8, CONV_N_GU, CONV_N_ALL); __syncthreads(); }
        if ((int)blockIdx.x < ngm) {
        moe_tables(p, F);
        pg8::Gemm g{(const bf16_t*)(ws + WS_X1B), (const bf16_t*)(ws + WS_WGU), DM / 2};
        pg8::MoeOrder S; S.init((const LAS int*)(F.lds + L_TILE0), (const LAS int*)(F.lds + L_CNT), (const int*)(ws + WS_LTOK), 16, ngm, (int)blockIdx.x);
        EpiMoe1 E{(unsigned char*)(ws + WS_ACT), p.in[15], p.in[17], (const float*)(ws + WS_LRS), (const LAS int*)(F.lds + L_CNT)};
        pg8::gemm_phase<EpiMoe1, pg8::MoeOrder, true, true, false, true>(ring, g, S, E);
        } else moe_weight_convert(p, F, ((int)blockIdx.x - ngm) * 8 + F.wave, (F.G - ngm) * 8, CONV_N_GU, CONV_N_ALL);
    }
    SEAM(7);
    if (IN(8)) {
        moe_tables(p, F);
        pg8::Gemm g{(const bf16_t*)(ws + WS_ACT), (const bf16_t*)(ws + WS_WDN), DFF / 2};
        pg8::MoeOrder S; S.init((const LAS int*)(F.lds + L_TILE0), (const LAS int*)(F.lds + L_CNT), (const int*)(ws + WS_LTOK), 8, F.G, (int)blockIdx.x);
        EpiMoe2 E{(unsigned char*)(ws + WS_YS), p.in[19]};
        pg8::gemm_phase<EpiMoe2, pg8::MoeOrder, false, true, false, true>(ring, g, S, E);
    }
    SEAM(8);
    if (IN(9)) { moe_tables(p, F); p7_final(p, F); }
#undef IN
#undef SEAM
}

extern "C" void kernel_launch(void* const* d_in, const int* in_sizes, int n_in, void* d_out, int out_size, void* d_ws, size_t ws_size, hipStream_t stream) {
    static int grid = 0;
    if (grid == 0) {
        if (n_in != 21 || in_sizes[0] != T_TOK * DM || out_size != T_TOK * DM || ws_size < WS_END) { fprintf(stderr, "kernel_launch: unexpected shapes / workspace (n_in %d, ws %zu < %zu)\n", n_in, ws_size, (size_t)WS_END); grid = -1; return; }
        int dev = 0, cus = 0, per_cu = 0;
        if (hipGetDevice(&dev) != hipSuccess || hipDeviceGetAttribute(&cus, hipDeviceAttributeMultiprocessorCount, dev) != hipSuccess) { grid = -1; return; }
        if (hipFuncSetAttribute((const void*)hymba_fwd, hipFuncAttributeMaxDynamicSharedMemorySize, LDS_BYTES) != hipSuccess) { fprintf(stderr, "kernel_launch: hipFuncSetAttribute failed\n"); grid = -1; return; }
        if (hipOccupancyMaxActiveBlocksPerMultiprocessor(&per_cu, (const void*)hymba_fwd, 512, LDS_BYTES) != hipSuccess || per_cu < 1) { fprintf(stderr, "kernel_launch: occupancy query says %d\n", per_cu); }
        (void)hipGetLastError();
        grid = cus;
    }
    if (grid < 0) return;
    (void)hipMemsetAsync((char*)d_ws + WS_CTL, 0, CTL_ZERO_BYTES, stream);
    Params p{};
    for (int i = 0; i < 21; ++i) p.in[i] = (const float*)d_in[i];
    p.out = (float*)d_out; p.ws = (unsigned char*)d_ws; p.pad = 0;
#if MK_N_LAUNCHES == 1
    p.ph_lo = 0; p.ph_hi = N_PHASES; p.li = 0;
    hipLaunchKernelGGL(hymba_fwd, dim3(grid), dim3(512), LDS_BYTES, stream, p);
#else
    for (int k = 0; k < N_PHASES; ++k) { p.ph_lo = k; p.ph_hi = k + 1; p.li = 0; hipLaunchKernelGGL(hymba_fwd, dim3(grid), dim3(512), LDS_BYTES, stream, p); }
#endif
}
```

```cpp
#include <hip/hip_runtime.h>
#include <cstdio>
#include <cstdint>

#ifndef MK_N_LAUNCHES
#define MK_N_LAUNCHES 1
#endif

constexpr int T_TOK = 16384, SEQ = 8192, DM = 2048, D_IN = 7176, NPROJ = 7168;
constexpr int NCHUNK = 128;
constexpr int NEXP = 32, TOPK = 4, DFF = 2048;
constexpr int LIST_STRIDE = 16384;
constexpr int MAX_TILES = 288;
constexpr float EPS = 1e-6f;
constexpr int C_HQ = 0, C_HF = 1024, C_HI = 2048, C_HG = 3072, C_MQ = 4096, C_MK = 4608, C_MV = 5120, C_MO = 6144;

#define GAS __attribute__((address_space(1)))
#define LAS __attribute__((address_space(3)))
typedef unsigned short bf16_t;
typedef short bf16x8 __attribute__((ext_vector_type(8)));
typedef float f32x4 __attribute__((ext_vector_type(4)));
typedef float f32x16 __attribute__((ext_vector_type(16)));
typedef unsigned u32x4 __attribute__((ext_vector_type(4)));
typedef unsigned u32x2 __attribute__((ext_vector_type(2)));
typedef int i32x4 __attribute__((ext_vector_type(4)));
typedef int i32x8 __attribute__((ext_vector_type(8)));

typedef float f32x2_t __attribute__((ext_vector_type(2)));
typedef __bf16 bf16x2_t __attribute__((ext_vector_type(2)));
__device__ __forceinline__ unsigned cvt_pk_bf16(float lo, float hi) { const f32x2_t v = {lo, hi}; return __builtin_bit_cast(unsigned, __builtin_convertvector(v, bf16x2_t)); }
__device__ __forceinline__ unsigned cvt4_fp8(float a, float b, float c, float d) { int w = 0; w = __builtin_amdgcn_cvt_pk_fp8_f32(a, b, w, false); w = __builtin_amdgcn_cvt_pk_fp8_f32(c, d, w, true); return (unsigned)w; }
__device__ __forceinline__ float bf2f(bf16_t b) { return __uint_as_float(((unsigned)b) << 16); }
__device__ __forceinline__ float bflo(unsigned w) { return __uint_as_float(w << 16); }
__device__ __forceinline__ float bfhi(unsigned w) { return __uint_as_float(w & 0xffff0000u); }
__device__ __forceinline__ float sigmoidf_(float x) { return __builtin_amdgcn_rcpf(1.0f + __expf(-x)); }
__device__ __forceinline__ float sig1702_(float x) { return __builtin_amdgcn_rcpf(1.0f + __builtin_amdgcn_exp2f(x * -2.4554669f)); }

namespace pg8 {
constexpr int BM = 256, BK = 64, HALF = 128, HTB = HALF * BK * 2, STAGE_BYTES = 8 * HTB, NXCD = 8, WGM = 8;
__host__ __device__ __forceinline__ int lds_byte(int r, int c) { const int st = (r >> 4) * 2 + (c >> 5), rr = r & 15, cc = c & 31, ob = rr * 64 + cc * 2; return st * 1024 + (ob ^ (((ob >> 9) & 1) << 5)); }
__host__ __device__ __forceinline__ void stage_rc(int b, int& R, int& C) { const int st = b / 1024, sb = b % 1024, swz = sb ^ (((sb >> 9) & 1) << 5); R = (st >> 1) * 16 + swz / 64; C = (st & 1) * 32 + (swz % 64) / 2; }
__host__ __device__ __forceinline__ int perm32(int rho) { const int n = rho >> 4, i = rho & 15; return 8 * (i >> 2) + 4 * n + (i & 3); }

struct Unit { int pm, pn, e, r0; };
struct Gemm { const bf16_t* A; const bf16_t* Bt; int K; };

struct StaticOrder {
    int nM, nN, nwg, G, c;
    __device__ void init(int M, int N, int G_, int c_) { nM = M / BM; nN = N / BM; nwg = nM * nN; G = G_; c = c_; }
    __device__ bool next(int i, Unit& u) const {
        const long L = (long)i * G + c; if (L >= nwg) return false;
        int wgid = (int)L; { const int q = nwg / NXCD, r = nwg % NXCD, xcd = wgid % NXCD, off = wgid / NXCD; wgid = (xcd < r ? xcd * (q + 1) : r * (q + 1) + (xcd - r) * q) + off; }
        const int nig = WGM * nN, gid = wgid / nig, fm = gid * WGM, gsz = (nM - fm) < WGM ? (nM - fm) : WGM;
        u.pm = fm + ((wgid % nig) % gsz); u.pn = (wgid % nig) / gsz; u.e = 0; u.r0 = 0; return true;
    }
    __device__ __forceinline__ unsigned tok(const Unit&, int) const { return 0u; }
};
struct MoeOrder {
    const LAS int* tile0;
    const LAS int* cnt;
    const int* list_tok;
    int NC, nwg, G, c;
    __device__ void init(const LAS int* t0, const LAS int* cn, const int* lt, int NC_, int G_, int c_) { tile0 = t0; cnt = cn; list_tok = lt; NC = NC_; nwg = t0[NEXP] * NC_; G = G_; c = c_; }
    __device__ bool next(int i, Unit& u) const {
        const long L = (long)i * G + c; if (L >= nwg) return false;
        int wgid = (int)L; { const int q = nwg / NXCD, r = nwg % NXCD, xcd = wgid % NXCD, off = wgid / NXCD; wgid = (xcd < r ? xcd * (q + 1) : r * (q + 1) + (xcd - r) * q) + off; }
        int e = 0;
        for (int j = 1; j < NEXP; ++j) if (tile0[j] * NC <= wgid) e = j;
        const int nr = tile0[e + 1] - tile0[e], idx = wgid - tile0[e] * NC;
        const int r = idx % nr, cn = idx / nr;
        u.e = __builtin_amdgcn_readfirstlane(e); u.pm = __builtin_amdgcn_readfirstlane(tile0[e] + r); u.pn = __builtin_amdgcn_readfirstlane(e * NC + cn); u.r0 = __builtin_amdgcn_readfirstlane(r * BM); return true;
    }
    __device__ __forceinline__ unsigned tok(const Unit& u, int row) const { const int p = u.r0 + row; const bool ok = p < cnt[u.e]; const unsigned t = (unsigned)list_tok[u.e * LIST_STRIDE + (ok ? p : 0)]; return ok ? t : 0u; }
};

template <class Epi, class Sched, bool GATHER, bool ALIGN_EPI, bool SP2, bool FP8>
__device__ __forceinline__ void gemm_phase(LAS unsigned char* lds, const Gemm g, const Sched& S, const Epi& E) {
    const int tid = threadIdx.x, wid = __builtin_amdgcn_readfirstlane(tid >> 6), lane = tid & 63, wr = wid >> 2, wc = wid & 3, fr = lane & 15, fq = lane >> 4;
    const int K = g.K, nt = K / BK;
    u32x2 vA0, vA1; unsigned voffB[2];
    int Rr[2], Cc[2];
#pragma unroll
    for (int i = 0; i < 2; ++i) { int R, C; stage_rc(tid * 16 + i * 8192, R, C); Rr[i] = R; Cc[i] = C; const int Rb = (R & ~31) + perm32(R & 31); voffB[i] = (unsigned)(Rb * K + C) * 2u; }
    const int kstep = BK * 2;
    const int hstep = HALF * K * 2;
    const int tstep = 2 * hstep;
    const unsigned ldsw = (unsigned)wid * 1024u;
    const int aoff = lds_byte(wr * 64 + fr, fq * 8), boff = lds_byte(wc * 32 + fr, fq * 8);
    const __amdgpu_buffer_rsrc_t rsA = __builtin_amdgcn_make_buffer_rsrc((void*)g.A, 0, 0xFFFFFFF0u, 0x00020000);
    const __amdgpu_buffer_rsrc_t rsB = __builtin_amdgcn_make_buffer_rsrc((void*)g.Bt, 0, 0xFFFFFFF0u, 0x00020000);
#define PG8_OFFA(u, _row, _i) (GATHER ? (S.tok(u, _row) * (unsigned)(K * 2) + (unsigned)(Cc[_i] * 2)) : (unsigned)((_row) * K + Cc[_i]) * 2u)
#define PG8_SETA(d0, d1, u) do { d0.x = PG8_OFFA(u, Rr[0], 0); d0.y = PG8_OFFA(u, Rr[1], 1); d1.x = PG8_OFFA(u, HALF + Rr[0], 0); d1.y = PG8_OFFA(u, HALF + Rr[1], 1); } while (0)
#define PG8_SA(b, h) (((b) * 2 + (h)) * HTB)
#define PG8_SB(b, h) ((4 + (b) * 2 + (h)) * HTB)
#define PG8_STAGE_A(bufoff, soff, voff) do { _Pragma("unroll") for (int _i = 0; _i < 2; ++_i) \
        __builtin_amdgcn_raw_ptr_buffer_load_lds(rsA, (LAS void*)(lds + (bufoff) + ldsw + _i * 8192), 16, (voff)[_i], (soff), 0, 0); } while (0)
#define PG8_STAGE_B(bufoff, soff) do { _Pragma("unroll") for (int _i = 0; _i < 2; ++_i) \
        __builtin_amdgcn_raw_ptr_buffer_load_lds(rsB, (LAS void*)(lds + (bufoff) + ldsw + _i * 8192), 16, voffB[_i], (soff), 0, 0); } while (0)
#define PG8_LD8(base_) __builtin_shufflevector(*(const LAS i32x4*)(base_), *(const LAS i32x4*)((base_) + 1024), 0, 1, 2, 3, 4, 5, 6, 7)
#define PG8_LDA(dst, b, h) do { _Pragma("unroll") for (int m = 0; m < 4; ++m) dst[m] = PG8_LD8(lds + PG8_SA(b, h) + aoff + m * 2048); } while (0)
#define PG8_LDB(dst, b, h) do { _Pragma("unroll") for (int n = 0; n < 2; ++n) dst[n] = PG8_LD8(lds + PG8_SB(b, h) + boff + n * 2048); } while (0)
#define PG8_LO(v) __builtin_bit_cast(bf16x8, __builtin_shufflevector(v, v, 0, 1, 2, 3))
#define PG8_HI(v) __builtin_bit_cast(bf16x8, __builtin_shufflevector(v, v, 4, 5, 6, 7))
#define PG8_MMA(ai, bj, At, Bt) do { __builtin_amdgcn_s_setprio(1); _Pragma("unroll") for (int m = 0; m < 4; ++m) _Pragma("unroll") for (int n = 0; n < 2; ++n) { \
        if constexpr (FP8) asm volatile("v_mfma_f32_16x16x128_f8f6f4 %0, %1, %2, %0" : "+v"(acc[ai][bj][m][n]) : "v"(Bt[n]), "v"(At[m])); \
        else { asm volatile("v_mfma_f32_16x16x32_bf16 %0, %1, %2, %0" : "+v"(acc[ai][bj][m][n]) : "v"(PG8_LO(Bt[n])), "v"(PG8_LO(At[m]))); \
               asm volatile("v_mfma_f32_16x16x32_bf16 %0, %1, %2, %0" : "+v"(acc[ai][bj][m][n]) : "v"(PG8_HI(Bt[n])), "v"(PG8_HI(At[m]))); } } \
        __builtin_amdgcn_s_setprio(0); } while (0)
#define PG8_WAIT_V(n) asm volatile("s_waitcnt vmcnt(" #n ")" ::: "memory")
#define PG8_WAIT_L(n) asm volatile("s_waitcnt lgkmcnt(" #n ")" ::: "memory")
#define PG8_BAR __builtin_amdgcn_s_barrier()
#define PG8_SCHED __builtin_amdgcn_sched_barrier(0)
    Unit cur, nxt; int ui = 0;
    if (!S.next(0, cur)) return;
    typename Epi::Pre pre{};
    f32x4 acc[2][2][4][2];
#pragma unroll
    for (int a = 0; a < 2; ++a)
#pragma unroll
        for (int b = 0; b < 2; ++b)
#pragma unroll
            for (int m = 0; m < 4; ++m)
#pragma unroll
                for (int n = 0; n < 2; ++n) acc[a][b][m][n] = (f32x4){0.f, 0.f, 0.f, 0.f};
    i32x8 At[4], B0[2], B1[2];
    int cA = GATHER ? 0 : cur.pm * tstep, cB = cur.pn * tstep;
    PG8_SETA(vA0, vA1, cur);
    if constexpr (SP2) {
        PG8_STAGE_B(PG8_SB(0, 0), cB); PG8_STAGE_B(PG8_SB(0, 1), cB + hstep); PG8_STAGE_A(PG8_SA(0, 0), cA, vA0); PG8_STAGE_A(PG8_SA(0, 1), cA, vA1);
        if (wr == 1) PG8_BAR;
        PG8_WAIT_V(2); PG8_BAR;
        PG8_STAGE_B(PG8_SB(1, 0), cB + kstep); PG8_STAGE_A(PG8_SA(1, 0), cA + kstep, vA0); PG8_STAGE_B(PG8_SB(1, 1), cB + hstep + kstep);
        PG8_WAIT_V(6); PG8_BAR;
    } else {
        PG8_STAGE_B(PG8_SB(0, 0), cB); PG8_STAGE_A(PG8_SA(0, 0), cA, vA0); PG8_STAGE_B(PG8_SB(0, 1), cB + hstep); PG8_STAGE_A(PG8_SA(0, 1), cA, vA1);
        if (wr == 1) PG8_BAR;
        PG8_WAIT_V(4); PG8_BAR;
        PG8_STAGE_B(PG8_SB(1, 0), cB + kstep); PG8_STAGE_A(PG8_SA(1, 0), cA + kstep, vA0); PG8_STAGE_B(PG8_SB(1, 1), cB + hstep + kstep);
        PG8_WAIT_V(6); PG8_BAR;
    }
    for (;;) {
        const bool has_next = S.next(ui + 1, nxt);
        const int nA = has_next ? (GATHER ? 0 : nxt.pm * tstep) : cA, nB = has_next ? nxt.pn * tstep : cB;
        u32x2 nvA0 = vA0, nvA1 = vA1;
        if constexpr (GATHER) { if (has_next) PG8_SETA(nvA0, nvA1, nxt); }
        for (int t = 0; t < nt; t += 2) {
            const bool last = (t == nt - 2);
            if (last) pre = E.prefetch(cur, wr, wc, fr, fq);
            const int a1 = cA + (t + 1) * kstep;
            const int a2 = last ? nA : cA + (t + 2) * kstep, b2 = last ? nB : cB + (t + 2) * kstep;
            const int a3 = a2 + kstep, b3 = b2 + kstep;
            const u32x2 va20 = (GATHER && last) ? nvA0 : vA0, va21 = (GATHER && last) ? nvA1 : vA1;
            if constexpr (SP2) {
            PG8_LDB(B0, 0, 0); PG8_LDB(B1, 0, 1); PG8_SCHED; PG8_LDA(At, 0, 0); PG8_STAGE_A(PG8_SA(1, 1), a1, vA1);
            PG8_WAIT_V(8); PG8_WAIT_L(0); PG8_BAR; PG8_MMA(0, 0, At, B0); PG8_MMA(0, 1, At, B1); PG8_BAR; PG8_SCHED;
            PG8_LDA(At, 0, 1); PG8_STAGE_B(PG8_SB(0, 0), b2); PG8_STAGE_B(PG8_SB(0, 1), b2 + hstep); PG8_STAGE_A(PG8_SA(0, 0), a2, va20);
            PG8_WAIT_V(8); PG8_WAIT_L(0); PG8_BAR; PG8_MMA(1, 0, At, B0); PG8_MMA(1, 1, At, B1); PG8_BAR; PG8_SCHED;
            PG8_LDB(B0, 1, 0); PG8_LDB(B1, 1, 1); PG8_SCHED; PG8_LDA(At, 1, 0); PG8_STAGE_A(PG8_SA(0, 1), a2, va21);
            PG8_WAIT_V(8); PG8_WAIT_L(0); PG8_BAR; PG8_MMA(0, 0, At, B0); PG8_MMA(0, 1, At, B1); PG8_BAR; PG8_SCHED;
            PG8_LDA(At, 1, 1); PG8_STAGE_B(PG8_SB(1, 0), b3); PG8_STAGE_B(PG8_SB(1, 1), b3 + hstep); PG8_STAGE_A(PG8_SA(1, 0), a3, va20);
            PG8_WAIT_V(8); PG8_WAIT_L(0); PG8_BAR; PG8_MMA(1, 0, At, B0); PG8_MMA(1, 1, At, B1); PG8_BAR; PG8_SCHED;
            } else {
            PG8_LDB(B0, 0, 0); PG8_SCHED; PG8_LDA(At, 0, 0); PG8_STAGE_A(PG8_SA(1, 1), a1, vA1);
            PG8_WAIT_L(8); PG8_BAR; PG8_WAIT_L(0); PG8_MMA(0, 0, At, B0); PG8_BAR; PG8_SCHED;
            PG8_LDB(B1, 0, 1); PG8_STAGE_B(PG8_SB(0, 0), b2);
            PG8_BAR; PG8_WAIT_L(0); PG8_MMA(0, 1, At, B1); PG8_BAR;
            PG8_LDA(At, 0, 1); PG8_STAGE_A(PG8_SA(0, 0), a2, va20);
            PG8_BAR; PG8_WAIT_L(0); PG8_MMA(1, 0, At, B0); PG8_BAR; PG8_SCHED;
            PG8_STAGE_B(PG8_SB(0, 1), b2 + hstep);
            PG8_WAIT_V(6); PG8_BAR; PG8_MMA(1, 1, At, B1); PG8_BAR;
            PG8_LDB(B0, 1, 0); PG8_SCHED; PG8_LDA(At, 1, 0); PG8_STAGE_A(PG8_SA(0, 1), a2, va21);
            PG8_WAIT_L(8); PG8_BAR; PG8_WAIT_L(0); PG8_MMA(0, 0, At, B0); PG8_BAR; PG8_SCHED;
            PG8_LDB(B1, 1, 1); PG8_STAGE_B(PG8_SB(1, 0), b3);
            PG8_BAR; PG8_WAIT_L(0); PG8_MMA(0, 1, At, B1); PG8_BAR;
            PG8_LDA(At, 1, 1); PG8_STAGE_A(PG8_SA(1, 0), a3, va20);
            PG8_BAR; PG8_WAIT_L(0); PG8_MMA(1, 0, At, B0); PG8_BAR; PG8_SCHED;
            PG8_STAGE_B(PG8_SB(1, 1), b3 + hstep);
            PG8_WAIT_V(6); PG8_BAR; PG8_MMA(1, 1, At, B1); PG8_BAR;
            }
        }
        if constexpr (ALIGN_EPI) { if (wr == 0) PG8_BAR; }
        {
            asm volatile("s_nop 15\n\ts_nop 3" : "+v"(acc[0][0][0][0]), "+v"(acc[0][0][0][1]), "+v"(acc[0][0][1][0]), "+v"(acc[0][0][1][1]), "+v"(acc[0][0][2][0]), "+v"(acc[0][0][2][1]), "+v"(acc[0][0][3][0]), "+v"(acc[0][0][3][1]));
            asm volatile("" : "+v"(acc[0][1][0][0]), "+v"(acc[0][1][0][1]), "+v"(acc[0][1][1][0]), "+v"(acc[0][1][1][1]), "+v"(acc[0][1][2][0]), "+v"(acc[0][1][2][1]), "+v"(acc[0][1][3][0]), "+v"(acc[0][1][3][1]));
            asm volatile("" : "+v"(acc[1][0][0][0]), "+v"(acc[1][0][0][1]), "+v"(acc[1][0][1][0]), "+v"(acc[1][0][1][1]), "+v"(acc[1][0][2][0]), "+v"(acc[1][0][2][1]), "+v"(acc[1][0][3][0]), "+v"(acc[1][0][3][1]));
            asm volatile("" : "+v"(acc[1][1][0][0]), "+v"(acc[1][1][0][1]), "+v"(acc[1][1][1][0]), "+v"(acc[1][1][1][1]), "+v"(acc[1][1][2][0]), "+v"(acc[1][1][2][1]), "+v"(acc[1][1][3][0]), "+v"(acc[1][1][3][1]));
        }
        { Unit eu = cur; asm volatile("" : "+s"(eu.pm), "+s"(eu.pn), "+s"(eu.e), "+s"(eu.r0));
          int tid2 = threadIdx.x; asm volatile("" : "+v"(tid2));
          const int wid2 = __builtin_amdgcn_readfirstlane(tid2 >> 6), lane2 = tid2 & 63;
          E(acc, eu, pre, wid2 >> 2, wid2 & 3, lane2 & 15, lane2 >> 4); }
        if (!has_next) break;
#pragma unroll
        for (int a = 0; a < 2; ++a)
#pragma unroll
            for (int b = 0; b < 2; ++b)
#pragma unroll
                for (int m = 0; m < 4; ++m)
#pragma unroll
                    for (int n = 0; n < 2; ++n) acc[a][b][m][n] = (f32x4){0.f, 0.f, 0.f, 0.f};
        cur = nxt; cA = nA; cB = nB; ++ui;
        vA0 = nvA0; vA1 = nvA1;
        if constexpr (ALIGN_EPI) { if (wr == 1) PG8_BAR; }
    }
    PG8_WAIT_V(0);
    if constexpr (!ALIGN_EPI) { if (wr == 0) PG8_BAR; }
    PG8_BAR;
#undef PG8_SETA
#undef PG8_OFFA
#undef PG8_SA
#undef PG8_SB
#undef PG8_STAGE_A
#undef PG8_STAGE_B
#undef PG8_LDA
#undef PG8_LD8
#undef PG8_LO
#undef PG8_HI
#undef PG8_LDB
#undef PG8_MMA
#undef PG8_WAIT_V
#undef PG8_WAIT_L
#undef PG8_BAR
#undef PG8_SCHED
}
}

struct EpiProj {
    bf16_t* O; const float* rstd;
    static constexpr int NSTORE = 16;
    struct Pre { f32x4 ra, rb; };
    __device__ __forceinline__ Pre prefetch(const pg8::Unit& u, int wr, int, int fr, int) const { Pre q; const int row0 = u.pm * 256 + wr * 64 + fr;
#pragma unroll
        for (int i = 0; i < 4; ++i) { q.ra[i] = rstd[row0 + i * 16]; q.rb[i] = rstd[row0 + 128 + i * 16]; }
        return q; }
    __device__ __forceinline__ void operator()(const f32x4 (&acc)[2][2][4][2], const pg8::Unit& u, const Pre& pre, int wr, int wc, int fr, int fq) const {
        const int row0 = u.pm * 256 + wr * 64 + fr, col0 = u.pn * 256 + wc * 32 + 8 * fq;
        float rsv[8];
#pragma unroll
        for (int i = 0; i < 4; ++i) { rsv[i] = pre.ra[i]; rsv[4 + i] = pre.rb[i]; }
#pragma unroll
        for (int ai = 0; ai < 2; ++ai)
#pragma unroll
            for (int m = 0; m < 4; ++m) { const int row = row0 + ai * 128 + m * 16; const float rs = rsv[ai * 4 + m]; bf16_t* rowp = O + (size_t)row * NPROJ + col0;
#pragma unroll
                for (int bj = 0; bj < 2; ++bj) { const f32x4 v0 = acc[ai][bj][m][0] * rs, v1 = acc[ai][bj][m][1] * rs;
                    u32x4 w; w.x = cvt_pk_bf16(v0[0], v0[1]); w.y = cvt_pk_bf16(v0[2], v0[3]); w.z = cvt_pk_bf16(v1[0], v1[1]); w.w = cvt_pk_bf16(v1[2], v1[3]);
                    *(u32x4*)(rowp + bj * 128) = w; } }
    }
};
struct EpiOut {
    const float* X; float* X1; unsigned char* X1b; LAS unsigned char* scr;
    static constexpr int NSTORE = 64;
    struct Pre { int none; };
    __device__ __forceinline__ Pre prefetch(const pg8::Unit&, int, int, int, int) const { return Pre{0}; }
    __device__ __forceinline__ void operator()(const f32x4 (&acc)[2][2][4][2], const pg8::Unit& u, const Pre&, int wr, int wc, int fr, int fq) const {
        const int lane = fr | (fq << 4), rr = lane >> 3, pc = lane & 7;
        LAS unsigned char* slab = scr + (wr * 4 + wc) * 2048;
        LAS unsigned char* wp0 = slab + fr * 128 + (((2 * fq) ^ (fr & 7)) << 4); LAS unsigned char* wp1 = slab + fr * 128 + (((2 * fq + 1) ^ (fr & 7)) << 4);
        const LAS unsigned char* rp0 = slab + rr * 128 + ((pc ^ (rr & 7)) << 4); const LAS unsigned char* rp1 = rp0 + 1024;
        const size_t base = (size_t)(u.pm * 256 + wr * 64 + rr) * DM + u.pn * 256 + wc * 32 + 4 * pc;
        f32x4 xa[2][2], xb[2][2];
#define EPO_LOAD(dst, g) do { const size_t off_ = base + (size_t)(((g) >> 2) * 128 + ((g) & 3) * 16) * DM; \
        _Pragma("unroll") for (int bj_ = 0; bj_ < 2; ++bj_) { dst[bj_][0] = *(const f32x4*)(X + off_ + bj_ * 128); dst[bj_][1] = *(const f32x4*)(X + off_ + bj_ * 128 + (size_t)8 * DM); } } while (0)
#define EPO_DO(src, g) do { const int ai_ = (g) >> 2, m_ = (g) & 3; const size_t off_ = base + (size_t)(ai_ * 128 + m_ * 16) * DM; \
        _Pragma("unroll") for (int bj_ = 0; bj_ < 2; ++bj_) { *(LAS f32x4*)wp0 = acc[ai_][bj_][m_][0]; *(LAS f32x4*)wp1 = acc[ai_][bj_][m_][1]; \
            const f32x4 v0 = *(const LAS f32x4*)rp0 + src[bj_][0], v1 = *(const LAS f32x4*)rp1 + src[bj_][1]; \
            *(f32x4*)(X1 + off_ + bj_ * 128) = v0; *(f32x4*)(X1 + off_ + bj_ * 128 + (size_t)8 * DM) = v1; \
            *(unsigned*)(X1b + off_ + bj_ * 128) = cvt4_fp8(v0[0], v0[1], v0[2], v0[3]); *(unsigned*)(X1b + off_ + bj_ * 128 + (size_t)8 * DM) = cvt4_fp8(v1[0], v1[1], v1[2], v1[3]); } } while (0)
        EPO_LOAD(xa, 0);
        EPO_LOAD(xb, 1); __builtin_amdgcn_sched_barrier(0); EPO_DO(xa, 0); __builtin_amdgcn_sched_barrier(0);
        EPO_LOAD(xa, 2); __builtin_amdgcn_sched_barrier(0); EPO_DO(xb, 1); __builtin_amdgcn_sched_barrier(0);
        EPO_LOAD(xb, 3); __builtin_amdgcn_sched_barrier(0); EPO_DO(xa, 2); __builtin_amdgcn_sched_barrier(0);
        EPO_LOAD(xa, 4); __builtin_amdgcn_sched_barrier(0); EPO_DO(xb, 3); __builtin_amdgcn_sched_barrier(0);
        EPO_LOAD(xb, 5); __builtin_amdgcn_sched_barrier(0); EPO_DO(xa, 4); __builtin_amdgcn_sched_barrier(0);
        EPO_LOAD(xa, 6); __builtin_amdgcn_sched_barrier(0); EPO_DO(xb, 5); __builtin_amdgcn_sched_barrier(0);
        EPO_LOAD(xb, 7); __builtin_amdgcn_sched_barrier(0); EPO_DO(xa, 6); __builtin_amdgcn_sched_barrier(0);
        EPO_DO(xb, 7);
#undef EPO_LOAD
#undef EPO_DO
    }
};
struct EpiMoe1 {
    unsigned char* ACT; const float* bg; const float* bu; const float* list_rs; const LAS int* cnt;
    static constexpr int NSTORE = 8;
    struct Pre { f32x4 g0, g1, u0, u1; };
    __device__ __forceinline__ Pre prefetch(const pg8::Unit& u, int wr, int wc, int fr, int fq) const { Pre q; const int e = u.e, cn = u.pn - e * 16, col = cn * 128 + wc * 32 + 8 * fq, ce = cnt[e];
        q.g0 = *(const f32x4*)(bg + e * DFF + col); q.g1 = *(const f32x4*)(bg + e * DFF + col + 4); q.u0 = *(const f32x4*)(bu + e * DFF + col); q.u1 = *(const f32x4*)(bu + e * DFF + col + 4);
        (void)ce; (void)wr; (void)fr; return q; }
    __device__ __forceinline__ void operator()(const f32x4 (&acc)[2][2][4][2], const pg8::Unit& u, const Pre& pre, int wr, int wc, int fr, int fq) const {
        const int e = u.e, cn = u.pn - e * 16, col = cn * 128 + wc * 32 + 8 * fq, ce = cnt[e];
        const f32x4 g0 = pre.g0, g1 = pre.g1, u0 = pre.u0, u1 = pre.u1;
        float rsv[8];
#pragma unroll
        for (int i = 0; i < 8; ++i) { const int p = u.r0 + (i >> 2) * 128 + wr * 64 + (i & 3) * 16 + fr; rsv[i] = list_rs[e * LIST_STRIDE + (p < ce ? p : 0)]; }
#pragma unroll
        for (int ai = 0; ai < 2; ++ai)
#pragma unroll
            for (int m = 0; m < 4; ++m) { const int rit = ai * 128 + wr * 64 + m * 16 + fr, p = u.r0 + rit; const float rs = (p < ce) ? rsv[ai * 4 + m] * 0.015625f : 0.f;
                f32x4 gt0 = acc[ai][0][m][0] * rs + g0, gt1 = acc[ai][0][m][1] * rs + g1, up0 = acc[ai][1][m][0] * rs + u0, up1 = acc[ai][1][m][1] * rs + u1;
                float o[8];
#pragma unroll
                for (int j = 0; j < 4; ++j) { float gv = fminf(gt0[j], 7.0f), uv = fminf(fmaxf(up0[j], -7.0f), 7.0f); o[j] = (uv + 1.0f) * (gv * sig1702_(gv));
                    gv = fminf(gt1[j], 7.0f); uv = fminf(fmaxf(up1[j], -7.0f), 7.0f); o[4 + j] = (uv + 1.0f) * (gv * sig1702_(gv)); }
                u32x2 w; w.x = cvt4_fp8(o[0], o[1], o[2], o[3]); w.y = cvt4_fp8(o[4], o[5], o[6], o[7]);
                *(u32x2*)(ACT + (size_t)(u.pm * 256 + rit) * DFF + col) = w; }
    }
};
struct EpiMoe2 {
    unsigned char* YS; const float* bd;
    static constexpr int NSTORE = 16;
    struct Pre { f32x4 bv[2][2]; };
    __device__ __forceinline__ Pre prefetch(const pg8::Unit& u, int wr, int wc, int fr, int fq) const { Pre q; const int e = u.e, cn = u.pn - e * 8, col0 = cn * 256 + wc * 32 + 8 * fq;
#pragma unroll
        for (int bj = 0; bj < 2; ++bj) { q.bv[bj][0] = *(const f32x4*)(bd + e * DM + col0 + bj * 128); q.bv[bj][1] = *(const f32x4*)(bd + e * DM + col0 + bj * 128 + 4); }
        return q; }
    __device__ __forceinline__ void operator()(const f32x4 (&acc)[2][2][4][2], const pg8::Unit& u, const Pre& pre, int wr, int wc, int fr, int fq) const {
        const int e = u.e, cn = u.pn - e * 8, col0 = cn * 256 + wc * 32 + 8 * fq;
        f32x4 bv[2][2];
#pragma unroll
        for (int bj = 0; bj < 2; ++bj) { bv[bj][0] = pre.bv[bj][0]; bv[bj][1] = pre.bv[bj][1]; }
#pragma unroll
        for (int ai = 0; ai < 2; ++ai)
#pragma unroll
            for (int m = 0; m < 4; ++m) { unsigned char* rowp = YS + (size_t)(u.pm * 256 + ai * 128 + wr * 64 + m * 16 + fr) * DM + col0;
#pragma unroll
                for (int bj = 0; bj < 2; ++bj) { const f32x4 v0 = acc[ai][bj][m][0] * 0.015625f + bv[bj][0], v1 = acc[ai][bj][m][1] * 0.015625f + bv[bj][1];
                    u32x2 w; w.x = cvt4_fp8(v0[0], v0[1], v0[2], v0[3]); w.y = cvt4_fp8(v1[0], v1[1], v1[2], v1[3]);
                    *(u32x2*)(rowp + bj * 128) = w; } }
    }
};

#define XB_TMO      128
#define XB_XCNT(j)  (256  + 64 * (j))
#define XB_XSUB(j)  (1280 + 64 * (j))
#define XB_XGEN(j)  (2304 + 64 * (j))
#define XB_TOP      3328
#define XB_TOPGEN   3392
#define XCD_BAR_WORDS 3456
#define XB_SPIN_CAP (1u << 18)
__device__ __forceinline__ unsigned xb_ld(unsigned* p)              { return __hip_atomic_load(p, __ATOMIC_RELAXED, __HIP_MEMORY_SCOPE_AGENT); }
__device__ __forceinline__ unsigned xb_add(unsigned* p, unsigned v) { return __hip_atomic_fetch_add(p, v, __ATOMIC_RELAXED, __HIP_MEMORY_SCOPE_AGENT); }
__device__ __forceinline__ unsigned xb_xcc_id() { return (unsigned)__builtin_amdgcn_s_getreg((3 << 11) | 20) & 0xFu; }
#define XB_SPIN(cond, bar) do { unsigned _sp = 0; while (cond) { __builtin_amdgcn_s_sleep(1); \
    if ((++_sp & 255u) == 0u) { if (xb_ld(&(bar)[XB_TMO])) break; if (_sp > XB_SPIN_CAP) { atomicAdd(&(bar)[XB_TMO], 1u); break; } } } } while (0)
struct XcdBarrier { unsigned* bar; unsigned x; volatile LAS unsigned* st; };
__device__ __forceinline__ XcdBarrier xcd_barrier_post(unsigned* bar, volatile LAS unsigned* st) {
    XcdBarrier b; b.bar = bar; b.x = xb_xcc_id(); b.st = st;
    if (threadIdx.x == 0) (void)xb_add(&bar[XB_XCNT(b.x)], 1u);
    return b;
}
__device__ __forceinline__ void xcd_barrier_complete(unsigned* bar, unsigned x, unsigned& nloc, unsigned& nx) {
    const unsigned G = gridDim.x * gridDim.y * gridDim.z;
    unsigned sum, cnt, mine, sp = 0u;
    for (;;) {
        sum = 0u; cnt = 0u; mine = 0u;
#pragma unroll
        for (unsigned j = 0; j < 16; ++j) { const unsigned c = xb_ld(&bar[XB_XCNT(j)]); sum += c; cnt += (c > 0u) ? 1u : 0u; mine = (j == x) ? c : mine; }
        if (sum == G) break;
        __builtin_amdgcn_s_sleep(1);
        if ((++sp & 255u) == 0u) { if (xb_ld(&bar[XB_TMO])) break; if (sp > XB_SPIN_CAP) { atomicAdd(&bar[XB_TMO], 1u); break; } }
    }
    nloc = mine > 0u ? mine : 1u; nx = cnt > 0u ? cnt : 1u;
}
__device__ __forceinline__ void xcd_barrier(const XcdBarrier& b) {
    asm volatile("s_waitcnt vmcnt(0)" ::: "memory");
    __syncthreads();
    if (threadIdx.x == 0) {
        unsigned* bar = b.bar;
        __builtin_amdgcn_s_waitcnt(0);
        unsigned nloc = b.st[0], nx = b.st[1];
        if (nloc == 0u) { xcd_barrier_complete(bar, b.x, nloc, nx); b.st[0] = nloc; b.st[1] = nx; }
        const unsigned old = xb_add(&bar[XB_XSUB(b.x)], 1u);
        const unsigned gen = old / nloc;
        if (old + 1u == (gen + 1u) * nloc) {
            __builtin_amdgcn_fence(__ATOMIC_RELEASE, "agent");
            asm volatile("s_waitcnt vmcnt(0)" ::: "memory");
            const unsigned og = xb_add(&bar[XB_TOP], 1u);
            const unsigned tg = og / nx;
            if (og + 1u == (tg + 1u) * nx) xb_add(&bar[XB_TOPGEN], 1u);
            else XB_SPIN(xb_ld(&bar[XB_TOPGEN]) == tg, bar);
            __builtin_amdgcn_fence(__ATOMIC_ACQUIRE, "agent");
            xb_add(&bar[XB_XGEN(b.x)], 1u);
            asm volatile("s_waitcnt vmcnt(0)" ::: "memory");
        } else {
            XB_SPIN(xb_ld(&bar[XB_XGEN(b.x)]) == gen, bar);
            __builtin_amdgcn_fence(__ATOMIC_ACQUIRE, "agent");
            asm volatile("s_waitcnt vmcnt(0)" ::: "memory");
        }
    }
    __syncthreads();
}

constexpr size_t MiB = 1u << 20;
constexpr size_t WS_CTL = 0, CTL_ZERO_BYTES = 1 * MiB;
constexpr int CW_BAR = 4096;
constexpr int CW_CNT = 64;
constexpr size_t WS_RSTD1 = 1 * MiB;
constexpr size_t WS_GATES = WS_RSTD1 + 64 * 1024;
constexpr size_t WS_RSTD2 = WS_GATES + 512 * 1024;
constexpr size_t WS_TOKE  = WS_RSTD2 + 64 * 1024;
constexpr size_t WS_TOKP  = WS_TOKE + 256 * 1024;
constexpr size_t WS_TOKG  = WS_TOKP + 256 * 1024;
constexpr size_t WS_LTOK  = 3 * MiB;
constexpr size_t WS_LRS   = 5 * MiB;
constexpr size_t WS_DVEC  = 7 * MiB;
constexpr size_t WS_DN    = 8 * MiB;
constexpr size_t WS_NST   = 8 * MiB + 512 * 1024;
constexpr size_t WS_MSC   = 9 * MiB;
constexpr size_t WS_MST   = 9 * MiB + 64 * 1024;
constexpr size_t WS_WGU   = 16 * MiB;
constexpr size_t WS_WDN   = WS_WGU + 512 * MiB;
constexpr size_t WS_WOUT  = WS_WDN + 256 * MiB;
constexpr size_t WS_X1    = WS_WOUT + 8 * MiB;
constexpr size_t WS_X1B   = WS_X1 + 128 * MiB;
constexpr size_t WS_S0    = WS_X1B + 64 * MiB;
constexpr size_t WS_XB    = WS_S0;
constexpr size_t WS_WIN   = WS_S0 + 64 * MiB;
constexpr size_t WS_PROJ  = WS_S0 + 96 * MiB;
constexpr size_t WS_DS    = WS_S0 + 320 * MiB;
constexpr size_t WS_DC    = WS_S0 + 448 * MiB;
constexpr size_t WS_SST   = WS_S0;
constexpr size_t WS_CST   = WS_S0 + 576 * MiB;
constexpr size_t WS_MIX   = WS_S0 + 640 * MiB;
constexpr size_t WS_ACT   = WS_S0;
constexpr size_t WS_YS    = WS_S0 + 288 * MiB;
constexpr size_t WS_END   = WS_S0 + 704 * MiB;

constexpr int RING_BYTES = 131072;
constexpr int LDSCTL_OFF = 162816;
constexpr int L_MISC = LDSCTL_OFF;
constexpr int L_TILE0 = LDSCTL_OFF + 256;
constexpr int L_CNT = LDSCTL_OFF + 512;
constexpr int L_HIST = LDSCTL_OFF + 768;
constexpr int LDS_BYTES = 163840;

struct Params {
    const float* in[21]; float* out; unsigned char* ws; int ph_lo, ph_hi, li, pad;
};
struct Frame { LAS unsigned char* lds; int tid, lane, wave, G, vcu; };

__device__ __forceinline__ float wave_sum(float v) {
#pragma unroll
    for (int o = 1; o < 64; o <<= 1) v += __shfl_xor(v, o);
    return v;
}

__device__ __forceinline__ void p0_transpose_item(const float* W, int ldw, int k0, int n0, bf16_t* WT, int K, int drow0, const float* sc, LAS float* scr, int lane) {
#pragma unroll 8
    for (int i = 0; i < 32; ++i) { const int kk = 2 * i + (lane >> 5); scr[kk * 33 + (lane & 31)] = W[(size_t)(k0 + kk) * ldw + n0 + (lane & 31)]; }
    const int c = lane & 7;
    float s8[8];
#pragma unroll
    for (int j = 0; j < 8; ++j) s8[j] = sc ? sc[k0 + 8 * c + j] : 1.0f;
    asm volatile("s_waitcnt lgkmcnt(0)" ::: "memory");
#pragma unroll
    for (int j = 0; j < 4; ++j) { const int n = (lane >> 3) + 8 * j; const LAS float* s = scr + (8 * c) * 33 + n;
        u32x4 o; o.x = cvt_pk_bf16(s[0 * 33] * s8[0], s[1 * 33] * s8[1]); o.y = cvt_pk_bf16(s[2 * 33] * s8[2], s[3 * 33] * s8[3]); o.z = cvt_pk_bf16(s[4 * 33] * s8[4], s[5 * 33] * s8[5]); o.w = cvt_pk_bf16(s[6 * 33] * s8[6], s[7 * 33] * s8[7]);
        *(u32x4*)(WT + (size_t)(drow0 + n) * K + k0 + 8 * c) = o; }
    asm volatile("s_waitcnt lgkmcnt(0)" ::: "memory");
}

__device__ __forceinline__ void p0_transpose_item_bf16(const float* W, int ldw, int k0, int n0, bf16_t* WT, int K, int drow0, const float* sc, LAS unsigned char* tile, int lane) {
    const int kq = lane >> 4, nq = lane & 15;
    const float* src = W + (size_t)(k0 + 4 * kq) * ldw + n0 + 4 * nq;
#pragma unroll
    for (int hb = 0; hb < 2; ++hb) {
        f32x4 v[4][4], sv[4];
        const float* scp = sc ? sc + k0 + 64 * hb + 4 * kq : src;
#pragma unroll
        for (int i = 0; i < 4; ++i) sv[i] = *(const f32x4*)(scp + (sc ? 16 * i : 0));
#pragma unroll
        for (int i = 0; i < 4; ++i)
#pragma unroll
            for (int j = 0; j < 4; ++j) v[i][j] = *(const f32x4*)(src + (size_t)(64 * hb + 16 * i + j) * ldw);
#pragma unroll
        for (int i = 0; i < 4; ++i) {
            const f32x4 s4 = sc ? sv[i] : (f32x4){1.f, 1.f, 1.f, 1.f};
#pragma unroll
            for (int nn = 0; nn < 4; ++nn) { u32x2 t; t.x = cvt_pk_bf16(v[i][0][nn] * s4[0], v[i][1][nn] * s4[1]); t.y = cvt_pk_bf16(v[i][2][nn] * s4[2], v[i][3][nn] * s4[3]);
                const int chunk = 2 * (4 * hb + i) + (kq >> 1);
                *(LAS u32x2*)(tile + (4 * nq + nn) * 256 + ((chunk ^ nq) << 4) + ((kq & 1) << 3)) = t; }
        }
    }
    asm volatile("s_waitcnt lgkmcnt(0)" ::: "memory");
#pragma unroll
    for (int r = 0; r < 16; ++r) { const int n = (lane >> 4) + 4 * r, c = lane & 15;
        const u32x4 o = *(const LAS u32x4*)(tile + n * 256 + ((c ^ ((n >> 2) & 15)) << 4));
        *(u32x4*)(WT + (size_t)(drow0 + n) * K + k0 + 8 * c) = o; }
    asm volatile("s_waitcnt lgkmcnt(0)" ::: "memory");
}

struct ConvItem { const float* W; unsigned char* WT; int sco; int k0, n0, drow0; };
__device__ __forceinline__ ConvItem conv_item(const Params& p, int it) {
    constexpr int I_E = (DM / 128) * (DFF / 64);
    const bool dn = it >= NEXP * 2 * I_E; const int j = dn ? it - NEXP * 2 * I_E : it;
    const int e = dn ? j / I_E : j / (2 * I_E), which = dn ? 2 : (j % (2 * I_E)) / I_E, r3 = j % I_E, nb = r3 % (DFF / 64), kb = r3 / (DFF / 64), n0 = nb * 64;
    ConvItem c; c.k0 = kb * 128; c.n0 = n0;
    if (which == 0) { c.W = p.in[14] + (size_t)e * DM * DFF; c.WT = (unsigned char*)(p.ws + WS_WGU) + (size_t)e * 4096 * DM; c.sco = 0; c.drow0 = (n0 >> 7) * 256 + (n0 & 127); }
    else if (which == 1) { c.W = p.in[16] + (size_t)e * DM * DFF; c.WT = (unsigned char*)(p.ws + WS_WGU) + (size_t)e * 4096 * DM; c.sco = 0; c.drow0 = (n0 >> 7) * 256 + 128 + (n0 & 127); }
    else { c.W = p.in[18] + (size_t)e * DFF * DM; c.WT = (unsigned char*)(p.ws + WS_WDN) + (size_t)e * DM * DFF; c.sco = 8192; c.drow0 = n0; }
    return c;
}
#define CONV_LOAD(dst, ci, half) do { const float* src_ = (ci).W + (size_t)((ci).k0 + 64 * (half) + 4 * kq) * 2048 + (ci).n0 + 4 * nq; \
        _Pragma("unroll") for (int i_ = 0; i_ < 4; ++i_) _Pragma("unroll") for (int j_ = 0; j_ < 4; ++j_) dst[i_][j_] = __builtin_nontemporal_load((const f32x4*)(src_ + (size_t)(16 * i_ + j_) * 2048)); } while (0)
#define CONV_PACK(srcv, ci, half) do { _Pragma("unroll") for (int i_ = 0; i_ < 4; ++i_) { \
        const f32x4 s4_ = *(const LAS f32x4*)(F.lds + (ci).sco + ((ci).k0 + 64 * (half) + 16 * i_ + 4 * kq) * 4); \
        _Pragma("unroll") for (int nn_ = 0; nn_ < 4; ++nn_) { const unsigned t_ = cvt4_fp8(srcv[i_][0][nn_] * s4_[0], srcv[i_][1][nn_] * s4_[1], srcv[i_][2][nn_] * s4_[2], srcv[i_][3][nn_] * s4_[3]); \
            const int n_ = 4 * nq + nn_, d_ = (4 * (4 * (half) + i_) + kq) ^ (4 * (nq & 7)); *(LAS unsigned*)(tile + n_ * 128 + d_ * 4) = t_; } } } while (0)
#define CONV_STORE(ci) do { asm volatile("s_waitcnt lgkmcnt(0)" ::: "memory"); \
        _Pragma("unroll") for (int r_ = 0; r_ < 8; ++r_) { const int n_ = (lane >> 3) + 8 * r_, c_ = lane & 7; const u32x4 o_ = *(const LAS u32x4*)(tile + n_ * 128 + 16 * (c_ ^ ((n_ >> 2) & 7))); \
            __builtin_nontemporal_store(o_, (u32x4*)((ci).WT + (size_t)((ci).drow0 + n_) * 2048 + (ci).k0 + 16 * c_)); } \
        asm volatile("s_waitcnt lgkmcnt(0)" ::: "memory"); } while (0)
__device__ __forceinline__ void moe_weight_convert(const Params& p, Frame& F, int gw, int NGW, int it0, int NIT) {
    LAS unsigned char* tile = F.lds + 16384 + F.wave * 8192;
    const int lane = F.lane, kq = lane >> 4, nq = lane & 15;
    __syncthreads();
    for (int i = F.tid; i < DM; i += 512) { *(LAS float*)(F.lds + 4 * i) = p.in[11][i] * 64.0f; *(LAS float*)(F.lds + 8192 + 4 * i) = 64.0f; }
    __syncthreads();
    int it = it0 + gw; if (it >= NIT) return;
    ConvItem cur = conv_item(p, it);
    f32x4 va[4][4], vb[4][4];
    CONV_LOAD(va, cur, 0);
    for (;;) {
        CONV_LOAD(vb, cur, 1);
        CONV_PACK(va, cur, 0);
        const int nit = it + NGW; const bool more = nit < NIT;
        const ConvItem nxt = conv_item(p, more ? nit : it);
        CONV_LOAD(va, nxt, 0);
        CONV_PACK(vb, cur, 1);
        CONV_STORE(cur);
        if (!more) break;
        cur = nxt; it = nit;
    }
}
#undef CONV_LOAD
#undef CONV_PACK
#undef CONV_STORE

template <int MODE>
__device__ __forceinline__ void skinny_f32(const float* X, int r0, int kbeg, const float* W, const float* lnw, bf16_t* XB, f32x16& acc, float& ssq, int lane) {
    const int m = lane & 31, kk = lane >> 5;
    const float* xr = X + (size_t)(r0 + m) * DM;
    ssq = 0.f;
    f32x4 a[4], lw[4], na[4], nlw[4]; float b[16], nb[16];
#define SK_LOAD(A_, LW_, B_, kb_) do { const int k0_ = (kb_) + 16 * kk; \
        _Pragma("unroll") for (int j_ = 0; j_ < 4; ++j_) { A_[j_] = *(const f32x4*)(xr + k0_ + 4 * j_); LW_[j_] = *(const f32x4*)(lnw + k0_ + 4 * j_); } \
        _Pragma("unroll") for (int j_ = 0; j_ < 16; ++j_) { if (MODE == 0) B_[j_] = (m < 8) ? W[(size_t)(k0_ + j_) * D_IN + NPROJ + m] : 0.f; else B_[j_] = W[(size_t)(k0_ + j_) * NEXP + m]; } } while (0)
    SK_LOAD(a, lw, b, kbeg);
#pragma unroll 1
    for (int kb = kbeg; kb < kbeg + 512; kb += 32) {
        const int k0 = kb + 16 * kk;
        if (kb + 32 < kbeg + 512) SK_LOAD(na, nlw, nb, kb + 32);
#pragma unroll
        for (int j = 0; j < 4; ++j) ssq += (a[j][0] * a[j][0] + a[j][1] * a[j][1]) + (a[j][2] * a[j][2] + a[j][3] * a[j][3]);
        if (MODE == 0) {
            u32x4 q0, q1;
            q0.x = cvt_pk_bf16(b[0] * lw[0][0], b[1] * lw[0][1]); q0.y = cvt_pk_bf16(b[2] * lw[0][2], b[3] * lw[0][3]); q0.z = cvt_pk_bf16(b[4] * lw[1][0], b[5] * lw[1][1]); q0.w = cvt_pk_bf16(b[6] * lw[1][2], b[7] * lw[1][3]);
            q1.x = cvt_pk_bf16(b[8] * lw[2][0], b[9] * lw[2][1]); q1.y = cvt_pk_bf16(b[10] * lw[2][2], b[11] * lw[2][3]); q1.z = cvt_pk_bf16(b[12] * lw[3][0], b[13] * lw[3][1]); q1.w = cvt_pk_bf16(b[14] * lw[3][2], b[15] * lw[3][3]);
            u32x4 w0, w1; w0.x = cvt_pk_bf16(a[0][0], a[0][1]); w0.y = cvt_pk_bf16(a[0][2], a[0][3]); w0.z = cvt_pk_bf16(a[1][0], a[1][1]); w0.w = cvt_pk_bf16(a[1][2], a[1][3]);
            w1.x = cvt_pk_bf16(a[2][0], a[2][1]); w1.y = cvt_pk_bf16(a[2][2], a[2][3]); w1.z = cvt_pk_bf16(a[3][0], a[3][1]); w1.w = cvt_pk_bf16(a[3][2], a[3][3]);
            bf16_t* o = XB + (size_t)(r0 + m) * DM + k0; *(u32x4*)o = w0; *(u32x4*)(o + 8) = w1;
            acc = __builtin_amdgcn_mfma_f32_32x32x16_bf16(__builtin_bit_cast(bf16x8, w0), __builtin_bit_cast(bf16x8, q0), acc, 0, 0, 0);
            acc = __builtin_amdgcn_mfma_f32_32x32x16_bf16(__builtin_bit_cast(bf16x8, w1), __builtin_bit_cast(bf16x8, q1), acc, 0, 0, 0);
        } else {
#pragma unroll
            for (int j = 0; j < 16; ++j) acc = __builtin_amdgcn_mfma_f32_32x32x2f32(a[j >> 2][j & 3], b[j] * lw[j >> 2][j & 3], acc, 0, 0, 0);
        }
#pragma unroll
        for (int j = 0; j < 4; ++j) { a[j] = na[j]; lw[j] = nlw[j]; }
#pragma unroll
        for (int j = 0; j < 16; ++j) b[j] = nb[j];
    }
#undef SK_LOAD
    ssq += __shfl_xor(ssq, 32);
}

__device__ __forceinline__ void p0_prologue(const Params& p, Frame& F) {
    unsigned char* ws = p.ws;
    {
        LAS float* part = (LAS float*)(F.lds);
        LAS float* ssqp = (LAS float*)(F.lds + 8192);
        const float* x = p.in[0]; const float* ln1 = p.in[1]; const float* win = p.in[2];
        bf16_t* xb = (bf16_t*)(ws + WS_XB);
        for (int blk = F.vcu; blk < T_TOK / 64; blk += F.G) {
            const int g = F.wave >> 2, ks = F.wave & 3, r0 = blk * 64 + g * 32;
            f32x16 acc;
#pragma unroll
            for (int i = 0; i < 16; ++i) acc[i] = 0.f;
            float ssq;
            skinny_f32<0>(x, r0, ks * 512, win, ln1, xb, acc, ssq, F.lane);
            const int n = F.lane & 31, hh = F.lane >> 5;
            if (n < 8) {
#pragma unroll
                for (int i = 0; i < 16; ++i) { const int row = (i & 3) + 8 * (i >> 2) + 4 * hh; part[((g * 4 + ks) * 32 + row) * 8 + n] = acc[i]; }
            }
            if (F.lane < 32) ssqp[(g * 4 + ks) * 32 + F.lane] = ssq;
            __syncthreads();
            if (F.tid < 64) {
                const int gg = F.tid >> 5, mm = F.tid & 31, t = blk * 64 + F.tid;
                float s = 0.f;
#pragma unroll
                for (int q = 0; q < 4; ++q) s += ssqp[(gg * 4 + q) * 32 + mm];
                const float rs = 1.0f / sqrtf(s * (1.0f / DM) + EPS);
                ((float*)(ws + WS_RSTD1))[t] = rs;
                float gt[8];
#pragma unroll
                for (int nn = 0; nn < 8; ++nn) { float v = 0.f;
#pragma unroll
                    for (int q = 0; q < 4; ++q) v += part[((gg * 4 + q) * 32 + mm) * 8 + nn];
                    gt[nn] = v * rs; }
                float* go = (float*)(ws + WS_GATES) + (size_t)t * 8;
                float bi[4], bf[4];
#pragma unroll
                for (int h = 0; h < 4; ++h) { bi[h] = p.in[7][h]; bf[h] = p.in[8][h]; }
                f32x4 o0, o1;
#pragma unroll
                for (int h = 0; h < 4; ++h) { o0[h] = gt[h] + bi[h]; const float f = gt[4 + h] + bf[h];
                    o1[h] = fminf(f, 0.f) - log1pf(__expf(-fabsf(f))); }
                *(f32x4*)go = o0; *(f32x4*)(go + 4) = o1;
            }
            __syncthreads();
        }
    }
    {
        LAS unsigned char* tile = F.lds + 16384 + F.wave * 16384;
        const int gw = F.vcu * 8 + F.wave, NGW = F.G * 8;
        constexpr int KB = DM / 128;
        constexpr int I_IN = KB * (NPROJ / 64), I_OUT = KB * (DM / 64);
        const float* ln1 = p.in[1];
        (void)I_OUT;
        for (int it = gw; it < I_IN; it += NGW) {
            const int nb = it % (NPROJ / 64), kb = it / (NPROJ / 64); p0_transpose_item_bf16(p.in[2], D_IN, kb * 128, nb * 64, (bf16_t*)(ws + WS_WIN), DM, nb * 64, ln1, tile, F.lane);
        }
    }
}
__device__ __forceinline__ void wout_transpose(const Params& p, Frame& F, int gw, int NGW) {
    LAS unsigned char* tile = F.lds + 16384 + F.wave * 16384;
    __syncthreads();
    for (int it = gw; it < (DM / 128) * (DM / 64); it += NGW) {
        const int nb = it % (DM / 64), kb = it / (DM / 64); p0_transpose_item_bf16(p.in[10], DM, kb * 128, nb * 64, (bf16_t*)(p.ws + WS_WOUT), DM, nb * 64, nullptr, tile, F.lane);
    }
    __syncthreads();
}

#define LBAR() do { asm volatile("s_waitcnt lgkmcnt(0)" ::: "memory"); __builtin_amdgcn_s_barrier(); asm volatile("" ::: "memory"); } while (0)
#define VLBAR() do { asm volatile("s_waitcnt vmcnt(0) lgkmcnt(0)" ::: "memory"); __builtin_amdgcn_s_barrier(); asm volatile("" ::: "memory"); } while (0)
template <int LPR>
__device__ __forceinline__ void dma_rows(LAS unsigned char* dst, const bf16_t* src, size_t gstride, int ninstr, int wave, int lane) {
    constexpr int RPI = 64 / LPR;
    asm volatile("" : "+v"(lane));
    for (int i = wave; i < ninstr; i += 8) { const int row = i * RPI + lane / LPR, c = lane % LPR;
        __builtin_amdgcn_global_load_lds((const unsigned*)(src + (size_t)row * gstride + c * 8), (LAS unsigned*)(dst + i * 1024), 16, 0, 0); }
}
__device__ __forceinline__ bf16x8 lds_frag(const LAS bf16_t* base, int row, int stride, int kofs) { return *(const LAS bf16x8*)(base + row * stride + kofs); }
__device__ __forceinline__ bf16_t f2bf(float v) { return (bf16_t)(cvt_pk_bf16(v, 0.f) & 0xffffu); }
__device__ __forceinline__ void hg_gate(float z, float lb, float& lf, float& kk) { const float f = lb + (1.0f - lb) * sigmoidf_(z); lf = __logf(f); kk = 1.0f - f; }

constexpr int TS = 136;
constexpr int TT = 72;

__device__ __forceinline__ void hg_local_phase(const Params& p, Frame& F) {
    unsigned char* ws = p.ws; const int tid = F.tid, lane = F.lane, w = F.wave;
    LAS bf16_t* KdT = (LAS bf16_t*)(F.lds + 65536); LAS bf16_t* VT = (LAS bf16_t*)(F.lds + 83968);
    LAS float* seg = (LAS float*)(F.lds + 102400);
#define HGL_ISSUE(it_, set_) do { const int sh_ = (it_) >> 7, c_ = (it_) & 127, b_ = sh_ >> 3, h_ = sh_ & 7; const bf16_t* pj_ = (const bf16_t*)(ws + WS_PROJ) + ((size_t)b_ * SEQ + (size_t)c_ * 64) * NPROJ; \
        dma_rows<16>(F.lds + (set_) * 32768, pj_ + C_HF + h_ * 128, NPROJ, 16, w, lane); dma_rows<16>(F.lds + (set_) * 32768 + 16384, pj_ + C_HI + h_ * 128, NPROJ, 16, w, lane); \
        nl0 = p.in[3][h_ * 128 + (tid & 127)]; nl1 = p.in[3][1024 + h_ * 128 + (tid & 127)]; } while (0)
    float nl0 = 0.f, nl1 = 0.f;
    LBAR();
    int item = F.vcu, set = 0;
    if (item < 2048) HGL_ISSUE(item, 0);
    asm volatile("s_waitcnt vmcnt(0)" ::: "memory");
    for (; item < 2048; item += F.G, set ^= 1) {
        const float l0 = nl0, l1 = nl1;
        LBAR();
        if (item + F.G < 2048) HGL_ISSUE(item + F.G, set ^ 1);
        const LAS bf16_t* ZR = (const LAS bf16_t*)(F.lds + set * 32768); const LAS bf16_t* VR = (const LAS bf16_t*)(F.lds + set * 32768 + 16384);
        const int k = tid & 127, tq = w >> 1;
        const float lb = 1.0f / (1.0f + __expf(l1 - l0));
        float cs[16], kk[16]; float run = 0.f;
#pragma unroll
        for (int j = 0; j < 16; ++j) { float lf; hg_gate(bf2f(ZR[(16 * tq + j) * 128 + k]), lb, lf, kk[j]); run += lf; cs[j] = run; }
        seg[tq * 128 + k] = run;
        { unsigned pk[8];
#pragma unroll
          for (int j = 0; j < 8; ++j) pk[j] = (unsigned)VR[(16 * tq + 2 * j) * 128 + k] | ((unsigned)VR[(16 * tq + 2 * j + 1) * 128 + k] << 16);
          *(LAS u32x4*)(VT + k * TT + 16 * tq) = (u32x4){pk[0], pk[1], pk[2], pk[3]}; *(LAS u32x4*)(VT + k * TT + 16 * tq + 8) = (u32x4){pk[4], pk[5], pk[6], pk[7]}; }
        LBAR();
        float off = 0.f, tot = 0.f;
#pragma unroll
        for (int q = 0; q < 4; ++q) { const float s = seg[q * 128 + k]; tot += s; if (q < tq) off += s; }
        { unsigned pk[8];
#pragma unroll
          for (int j = 0; j < 8; ++j) pk[j] = cvt_pk_bf16(kk[2 * j] * __expf(tot - (off + cs[2 * j])), kk[2 * j + 1] * __expf(tot - (off + cs[2 * j + 1])));
          *(LAS u32x4*)(KdT + k * TT + 16 * tq) = (u32x4){pk[0], pk[1], pk[2], pk[3]}; *(LAS u32x4*)(KdT + k * TT + 16 * tq + 8) = (u32x4){pk[4], pk[5], pk[6], pk[7]}; }
        const float dve = __expf(tot);
        LBAR();
        const int fr = lane & 15, fq = lane >> 4;
        bf16x8 bv[2];
#pragma unroll
        for (int ks = 0; ks < 2; ++ks) bv[ks] = lds_frag(VT, 16 * w + fr, TT, 32 * ks + 8 * fq);
        u32x2 o[8];
#pragma unroll
        for (int kb = 0; kb < 8; ++kb) { f32x4 acc = (f32x4){0.f, 0.f, 0.f, 0.f};
#pragma unroll
            for (int ks = 0; ks < 2; ++ks) acc = __builtin_amdgcn_mfma_f32_16x16x32_bf16(lds_frag(KdT, 16 * kb + fr, TT, 32 * ks + 8 * fq), bv[ks], acc, 0, 0, 0);
            o[kb].x = cvt_pk_bf16(acc[0], acc[1]); o[kb].y = cvt_pk_bf16(acc[2], acc[3]); }
        asm volatile("s_waitcnt vmcnt(0)" ::: "memory");
        bf16_t* dS = (bf16_t*)(ws + WS_DS) + ((size_t)((item >> 7) * 128 + 16 * w + fr) * 128 + (item & 127)) * 128 + 4 * fq;
#pragma unroll
        for (int kb = 0; kb < 8; ++kb) *(u32x2*)(dS + 16 * kb) = o[kb];
        if (tq == 0) ((float*)(ws + WS_DVEC))[(size_t)item * 128 + k] = dve;
    }
#undef HGL_ISSUE
}

__device__ __forceinline__ void ml_local_phase(const Params& p, Frame& F) {
    unsigned char* ws = p.ws; const int tid = F.tid, lane = F.lane, w = F.wave;
    LAS bf16_t* KT = (LAS bf16_t*)(F.lds + 100352); LAS bf16_t* VT = (LAS bf16_t*)(F.lds + 118784);
    LAS float* nred = (LAS float*)(F.lds + 155648);
    float nli = 0.f, nlf = 0.f;
#define MLL_ISSUE(it_, set_) do { const int sh_ = (it_) >> 7, c_ = (it_) & 127, b_ = sh_ >> 2, h_ = sh_ & 3; const size_t t0_ = (size_t)b_ * SEQ + (size_t)c_ * 64; const bf16_t* pj_ = (const bf16_t*)(ws + WS_PROJ) + t0_ * NPROJ; \
        dma_rows<16>(F.lds + (set_) * 50176, pj_ + C_MK + h_ * 128 - 3 * (size_t)NPROJ, NPROJ, 17, w, lane); dma_rows<32>(F.lds + (set_) * 50176 + 17408, pj_ + C_MV + h_ * 256, NPROJ, 32, w, lane); \
        const float* gt_ = (const float*)(ws + WS_GATES) + (t0_ + lane) * 8; nli = gt_[h_]; nlf = gt_[4 + h_]; \
        { const int ch_ = 512 + h_ * 128 + (tid & 127); ncw[0] = p.in[5][ch_]; ncw[1] = p.in[5][1024 + ch_]; ncw[2] = p.in[5][2048 + ch_]; ncw[3] = p.in[5][3072 + ch_]; ncw[4] = p.in[6][ch_]; } } while (0)
    float ncw[5] = {0.f, 0.f, 0.f, 0.f, 0.f};
    LBAR();
    int item = F.vcu, set = 0;
    if (item < 1024) MLL_ISSUE(item, 0);
    asm volatile("s_waitcnt vmcnt(0)" ::: "memory");
    for (; item < 1024; item += F.G, set ^= 1) {
        const int c = item & 127;
        const float li = nli, lf = nlf, w0 = ncw[0], w1 = ncw[1], w2 = ncw[2], w3 = ncw[3], cb = ncw[4];
        LBAR();
        if (item + F.G < 1024) MLL_ISSUE(item + F.G, set ^ 1);
        const LAS bf16_t* KR = (const LAS bf16_t*)(F.lds + set * 50176); const LAS bf16_t* VR = (const LAS bf16_t*)(F.lds + set * 50176 + 17408);
        float g = lf;
#pragma unroll
        for (int o = 1; o < 64; o <<= 1) { const float v = __shfl_up(g, o); if (lane >= o) g += v; }
        const float glast = __shfl(g, 63), lws = glast - g + li;
        float mx = lws;
#pragma unroll
        for (int o = 1; o < 64; o <<= 1) mx = fmaxf(mx, __shfl_xor(mx, o));
        const float wsl = __expf(lws - mx);
        { const int v = tid & 255, hf = tid >> 8; unsigned pk[16];
#pragma unroll
          for (int j = 0; j < 16; ++j) pk[j] = (unsigned)VR[(32 * hf + 2 * j) * 256 + v] | ((unsigned)VR[(32 * hf + 2 * j + 1) * 256 + v] << 16);
#pragma unroll
          for (int q = 0; q < 4; ++q) *(LAS u32x4*)(VT + v * TT + 32 * hf + 8 * q) = (u32x4){pk[4 * q], pk[4 * q + 1], pk[4 * q + 2], pk[4 * q + 3]}; }
        { const int d = tid & 127, tq = w >> 1;
          float r[19];
#pragma unroll
          for (int j = 0; j < 19; ++j) { const float v = bf2f(KR[(16 * tq + j) * 128 + d]); r[j] = (c == 0 && 16 * tq + j < 3) ? 0.f : v; }
          float kw[16]; float ns = 0.f;
#pragma unroll
          for (int j = 0; j < 16; ++j) { const float a = cb + w0 * r[j] + w1 * r[j + 1] + w2 * r[j + 2] + w3 * r[j + 3];
              const float wv = __uint_as_float(__builtin_amdgcn_readlane(__float_as_uint(wsl), 16 * tq + j)); kw[j] = a * sigmoidf_(a) * wv; ns += kw[j]; }
          unsigned pk[8];
#pragma unroll
          for (int j = 0; j < 8; ++j) pk[j] = cvt_pk_bf16(kw[2 * j], kw[2 * j + 1]);
          *(LAS u32x4*)(KT + d * TT + 16 * tq) = (u32x4){pk[0], pk[1], pk[2], pk[3]}; *(LAS u32x4*)(KT + d * TT + 16 * tq + 8) = (u32x4){pk[4], pk[5], pk[6], pk[7]};
          nred[tq * 128 + d] = ns; }
        LBAR();
        const float dnv = (tid < 128) ? (nred[tid] + nred[128 + tid]) + (nred[256 + tid] + nred[384 + tid]) : 0.f;
        const int fr = lane & 15, fq = lane >> 4;
        u32x2 o[2][8];
#pragma unroll
        for (int mb = 0; mb < 2; ++mb) {
            bf16x8 bv[2];
#pragma unroll
            for (int ks = 0; ks < 2; ++ks) bv[ks] = lds_frag(VT, 32 * w + 16 * mb + fr, TT, 32 * ks + 8 * fq);
#pragma unroll
            for (int db = 0; db < 8; ++db) { f32x4 acc = (f32x4){0.f, 0.f, 0.f, 0.f};
#pragma unroll
                for (int ks = 0; ks < 2; ++ks) acc = __builtin_amdgcn_mfma_f32_16x16x32_bf16(lds_frag(KT, 16 * db + fr, TT, 32 * ks + 8 * fq), bv[ks], acc, 0, 0, 0);
                o[mb][db].x = cvt_pk_bf16(acc[0], acc[1]); o[mb][db].y = cvt_pk_bf16(acc[2], acc[3]); }
        }
        asm volatile("s_waitcnt vmcnt(0)" ::: "memory");
#pragma unroll
        for (int mb = 0; mb < 2; ++mb) { bf16_t* dC = (bf16_t*)(ws + WS_DC) + ((size_t)((item >> 7) * 256 + 32 * w + 16 * mb + fr) * 128 + (item & 127)) * 128 + 4 * fq;
#pragma unroll
            for (int db = 0; db < 8; ++db) *(u32x2*)(dC + 16 * db) = o[mb][db]; }
        if (tid < 128) ((float*)(ws + WS_DN))[(size_t)item * 128 + tid] = dnv;
        if (tid == 0) { float* ms = (float*)(ws + WS_MSC) + (size_t)item * 4; ms[0] = glast; ms[1] = mx; }
    }
#undef MLL_ISSUE
}

__device__ __forceinline__ void p2_scan(const Params& p, Frame& F) {
    unsigned char* ws = p.ws;
    for (int gid = F.vcu * 512 + F.tid; gid < 131072; gid += F.G * 512) {
        if (gid < 65536) {
            const int sh = gid >> 12, rem = gid & 4095;
            const bf16_t* dS = (const bf16_t*)(ws + WS_DS) + (size_t)(sh * 128 + (rem >> 5)) * 16384 + (rem & 31) * 4;
            const float* dv = (const float*)(ws + WS_DVEC) + (size_t)sh * 128 * 128 + (rem & 31) * 4;
            bf16_t* so = (bf16_t*)(ws + WS_SST) + (size_t)sh * 128 * 16384 + rem * 4;
            f32x4 run = (f32x4){0.f, 0.f, 0.f, 0.f};
#pragma unroll 1
            for (int cb = 0; cb < NCHUNK; cb += 16) {
                u32x2 d[16]; f32x4 de[16];
#pragma unroll
                for (int j = 0; j < 16; ++j) { d[j] = *(const u32x2*)(dS + (size_t)(cb + j) * 128); de[j] = *(const f32x4*)(dv + (cb + j) * 128); }
#pragma unroll
                for (int j = 0; j < 16; ++j) {
                    u32x2 o; o.x = cvt_pk_bf16(run[0], run[1]); o.y = cvt_pk_bf16(run[2], run[3]);
                    *(u32x2*)(so + (size_t)(cb + j) * 16384) = o;
                    run = de[j] * run + (f32x4){bflo(d[j].x), bfhi(d[j].x), bflo(d[j].y), bfhi(d[j].y)};
                }
            }
        } else {
            const int g2 = gid - 65536, sh = g2 >> 13, rem = g2 & 8191;
            const bf16_t* dC = (const bf16_t*)(ws + WS_DC) + (size_t)(sh * 256 + (rem >> 5)) * 16384 + (rem & 31) * 4;
            const float* ms = (const float*)(ws + WS_MSC) + (size_t)sh * 128 * 4;
            bf16_t* co = (bf16_t*)(ws + WS_CST) + (size_t)sh * 128 * 32768 + rem * 4;
            const bool do_n = (rem < 32);
            const float* dn = (const float*)(ws + WS_DN) + (size_t)sh * 128 * 128 + (rem & 31) * 4;
            float* nst = (float*)(ws + WS_NST) + (size_t)sh * 128 * 128 + (rem & 31) * 4;
            float* mso = (float*)(ws + WS_MST) + (size_t)sh * 128;
            f32x4 run = (f32x4){0.f, 0.f, 0.f, 0.f}, nrun = (f32x4){0.f, 0.f, 0.f, 0.f}; float m = 0.f;
#pragma unroll 1
            for (int cb = 0; cb < NCHUNK; cb += 16) {
                u32x2 d[16]; float gl[16], ml[16]; f32x4 dnv[16];
#pragma unroll
                for (int j = 0; j < 16; ++j) { d[j] = *(const u32x2*)(dC + (size_t)(cb + j) * 128); gl[j] = ms[(cb + j) * 4]; ml[j] = ms[(cb + j) * 4 + 1]; }
#pragma unroll
                for (int j = 0; j < 16; ++j) dnv[j] = (f32x4){0.f, 0.f, 0.f, 0.f};
                if (do_n) {
#pragma unroll
                    for (int j = 0; j < 16; ++j) dnv[j] = *(const f32x4*)(dn + (cb + j) * 128);
                }
#pragma unroll
                for (int j = 0; j < 16; ++j) { const int c = cb + j;
                    const float mn = fmaxf(gl[j] + m, ml[j]), dec = __expf(gl[j] + m - mn), sl = __expf(ml[j] - mn);
                    u32x2 o; o.x = cvt_pk_bf16(run[0], run[1]); o.y = cvt_pk_bf16(run[2], run[3]);
                    *(u32x2*)(co + (size_t)c * 32768) = o;
                    if (do_n) { *(f32x4*)(nst + c * 128) = nrun; nrun = dec * nrun + sl * dnv[j]; if (rem == 0) mso[c] = m; }
                    run = dec * run + sl * (f32x4){bflo(d[j].x), bfhi(d[j].x), bflo(d[j].y), bfhi(d[j].y)}; m = mn;
                }
            }
        }
    }
}

__device__ __forceinline__ void hg_out_phase(const Params& p, Frame& F) {
    unsigned char* ws = p.ws; const int tid = F.tid, lane = F.lane, w = F.wave;
    LAS bf16_t* GR = (LAS bf16_t*)(F.lds + 98304); LAS bf16_t* VT = (LAS bf16_t*)(F.lds + 114688);
    LAS bf16_t* ATT = (LAS bf16_t*)(F.lds + 133120) + w * (16 * TT); LAS float* seg = (LAS float*)(F.lds + 151552); LAS float* ssqp = (LAS float*)(F.lds + 153600);
#define HGO_ISSUE_QZV(it_, set_) do { const int sh_ = (it_) >> 7, c_ = (it_) & 127, b_ = sh_ >> 3, h_ = sh_ & 7; const bf16_t* pj_ = (const bf16_t*)(ws + WS_PROJ) + ((size_t)b_ * SEQ + (size_t)c_ * 64) * NPROJ; \
        dma_rows<16>(F.lds + (set_) * 49152, pj_ + C_HQ + h_ * 128, NPROJ, 16, w, lane); dma_rows<16>(F.lds + (set_) * 49152 + 16384, pj_ + C_HF + h_ * 128, NPROJ, 16, w, lane); \
        dma_rows<16>(F.lds + (set_) * 49152 + 32768, pj_ + C_HI + h_ * 128, NPROJ, 16, w, lane); \
        nl0 = p.in[3][h_ * 128 + (tid & 127)]; nl1 = p.in[3][1024 + h_ * 128 + (tid & 127)]; \
        _Pragma("unroll") for (int nb_ = 0; nb_ < 4; ++nb_) nnw[nb_] = p.in[4][h_ * 128 + 16 * (4 * vh + nb_) + fr]; } while (0)
#define HGO_ISSUE_G(it_) do { const int sh_ = (it_) >> 7, c_ = (it_) & 127, b_ = sh_ >> 3, h_ = sh_ & 7; const bf16_t* pj_ = (const bf16_t*)(ws + WS_PROJ) + ((size_t)b_ * SEQ + (size_t)c_ * 64) * NPROJ; \
        dma_rows<16>((LAS unsigned char*)GR, pj_ + C_HG + h_ * 128, NPROJ, 16, w, lane); } while (0)
    const int fr = lane & 15, fq = lane >> 4, tb = w & 3, vh = w >> 2;
    float nl0 = 0.f, nl1 = 0.f, nnw[4] = {0.f, 0.f, 0.f, 0.f};
    LBAR();
    int item = F.vcu, set = 0;
    if (item < 2048) { HGO_ISSUE_QZV(item, 0); HGO_ISSUE_G(item); }
    asm volatile("s_waitcnt vmcnt(0)" ::: "memory");
    for (; item < 2048; item += F.G, set ^= 1) {
        const int sh = item >> 7, c = item & 127, b = sh >> 3, h = sh & 7; const size_t t0 = (size_t)b * SEQ + (size_t)c * 64;
        const float l0 = nl0, l1 = nl1, nw0 = nnw[0], nw1 = nnw[1], nw2 = nnw[2], nw3 = nnw[3];
        LBAR();
        if (item + F.G < 2048) HGO_ISSUE_QZV(item + F.G, set ^ 1);
        LAS bf16_t* QR = (LAS bf16_t*)(F.lds + set * 49152); LAS bf16_t* ZR = QR + 8192; LAS bf16_t* VR = QR + 16384;
        bf16x8 stf[4][4];
        { const bf16_t* ST = (const bf16_t*)(ws + WS_SST) + (size_t)item * 16384;
#pragma unroll
          for (int nb = 0; nb < 4; ++nb)
#pragma unroll
              for (int ks = 0; ks < 4; ++ks) stf[nb][ks] = *(const bf16x8*)(ST + (size_t)(16 * (4 * vh + nb) + fr) * 128 + 32 * ks + 8 * fq); }
        __builtin_amdgcn_sched_barrier(0);
        const int k = tid & 127, tq = w >> 1;
        const float lb = 1.0f / (1.0f + __expf(l1 - l0));
        float cs[16], kk[16], rq[16]; float run = 0.f;
#pragma unroll
        for (int j = 0; j < 16; ++j) { float lf; hg_gate(bf2f(ZR[(16 * tq + j) * 128 + k]), lb, lf, kk[j]); run += lf; cs[j] = run; rq[j] = bf2f(QR[(16 * tq + j) * 128 + k]); }
        seg[tq * 128 + k] = run;
        { unsigned pk[8];
#pragma unroll
          for (int j = 0; j < 8; ++j) pk[j] = (unsigned)VR[(16 * tq + 2 * j) * 128 + k] | ((unsigned)VR[(16 * tq + 2 * j + 1) * 128 + k] << 16);
          *(LAS u32x4*)(VT + k * TT + 16 * tq) = (u32x4){pk[0], pk[1], pk[2], pk[3]}; *(LAS u32x4*)(VT + k * TT + 16 * tq + 8) = (u32x4){pk[4], pk[5], pk[6], pk[7]}; }
        LBAR();
        { float off = 0.f;
#pragma unroll
          for (int q = 0; q < 4; ++q) { const float s = seg[q * 128 + k]; if (q < tq) off += s; }
#pragma unroll
          for (int j = 0; j < 16; ++j) { const float bt = off + cs[j]; const int t = 16 * tq + j, sw = t * 128 + ((((k >> 3) ^ (t & 15)) << 3) | (k & 7));
              QR[sw] = f2bf(rq[j] * __expf(bt)); ZR[sw] = f2bf(kk[j] * __expf(-bt)); } }
        float gv[4][4];
#pragma unroll
        for (int i = 0; i < 4; ++i)
#pragma unroll
            for (int nb = 0; nb < 4; ++nb) gv[i][nb] = bf2f(GR[(16 * tb + 4 * fq + i) * 128 + 16 * (4 * vh + nb) + fr]);
        LBAR();
        if (item + F.G < 2048) HGO_ISSUE_G(item + F.G);
        bf16x8 aq[4];
#pragma unroll
        for (int ks = 0; ks < 4; ++ks) aq[ks] = *(const LAS bf16x8*)(QR + (16 * tb + fr) * 128 + (((4 * ks + fq) ^ fr) << 3));
#pragma unroll
        for (int sb = 0; sb < 4; ++sb) {
            f32x4 acc = (f32x4){0.f, 0.f, 0.f, 0.f};
            if (sb <= tb) {
#pragma unroll
                for (int ks = 0; ks < 4; ++ks) acc = __builtin_amdgcn_mfma_f32_16x16x32_bf16(aq[ks], *(const LAS bf16x8*)(ZR + (16 * sb + fr) * 128 + (((4 * ks + fq) ^ fr) << 3)), acc, 0, 0, 0);
            }
#pragma unroll
            for (int i = 0; i < 4; ++i) { const int tl = 16 * tb + 4 * fq + i, s = 16 * sb + fr; ATT[(4 * fq + i) * TT + s] = f2bf((s <= tl) ? acc[i] : 0.f); }
        }
        f32x4 o[4];
#pragma unroll
        for (int nb = 0; nb < 4; ++nb) { o[nb] = (f32x4){0.f, 0.f, 0.f, 0.f};
#pragma unroll
            for (int ks = 0; ks < 4; ++ks) o[nb] = __builtin_amdgcn_mfma_f32_16x16x32_bf16(aq[ks], stf[nb][ks], o[nb], 0, 0, 0); }
        asm volatile("s_waitcnt lgkmcnt(0)" ::: "memory");
        bf16x8 aa[2];
#pragma unroll
        for (int ks = 0; ks < 2; ++ks) aa[ks] = lds_frag(ATT, fr, TT, 32 * ks + 8 * fq);
#pragma unroll
        for (int nb = 0; nb < 4; ++nb) { const int vrow = 16 * (4 * vh + nb) + fr;
#pragma unroll
            for (int ks = 0; ks < 2; ++ks) o[nb] = __builtin_amdgcn_mfma_f32_16x16x32_bf16(aa[ks], lds_frag(VT, vrow, TT, 32 * ks + 8 * fq), o[nb], 0, 0, 0); }
        float sq[4];
#pragma unroll
        for (int i = 0; i < 4; ++i) { float s = 0.f;
#pragma unroll
            for (int nb = 0; nb < 4; ++nb) s += o[nb][i] * o[nb][i];
            s += __shfl_xor(s, 1); s += __shfl_xor(s, 2); s += __shfl_xor(s, 4); s += __shfl_xor(s, 8); sq[i] = s; }
        if (fr == 0) {
#pragma unroll
            for (int i = 0; i < 4; ++i) ssqp[vh * 64 + 16 * tb + 4 * fq + i] = sq[i]; }
        LBAR();
        const float nwv[4] = {nw0, nw1, nw2, nw3};
#pragma unroll
        for (int i = 0; i < 4; ++i) { const int tl = 16 * tb + 4 * fq + i; const float r = 1.0f / sqrtf((ssqp[tl] + ssqp[64 + tl]) * (1.0f / 128.0f) + EPS);
#pragma unroll
            for (int nb = 0; nb < 4; ++nb) { const int v = 16 * (4 * vh + nb) + fr; const float g = gv[i][nb];
                VR[tl * 128 + v] = f2bf(o[nb][i] * r * nwv[nb] * (g * sigmoidf_(g))); } }
        LBAR();
        u32x4 ov[2];
#pragma unroll
        for (int q = 0; q < 2; ++q) { const int cix = tid + 512 * q; ov[q] = *(const LAS u32x4*)(VR + (cix >> 4) * 128 + (cix & 15) * 8); }
        asm volatile("s_waitcnt vmcnt(0)" ::: "memory");
        bf16_t* mix = (bf16_t*)(ws + WS_MIX) + t0 * DM + h * 128;
#pragma unroll
        for (int q = 0; q < 2; ++q) { const int cix = tid + 512 * q; *(u32x4*)(mix + (size_t)(cix >> 4) * DM + (cix & 15) * 8) = ov[q]; }
    }
#undef HGO_ISSUE_QZV
#undef HGO_ISSUE_G
}

__device__ __forceinline__ void ml_out_phase(const Params& p, Frame& F) {
    unsigned char* ws = p.ws; const int tid = F.tid, lane = F.lane, w = F.wave;
    LAS bf16_t* QR = (LAS bf16_t*)(F.lds); LAS bf16_t* KR = (LAS bf16_t*)(F.lds + 17408); LAS bf16_t* VR = (LAS bf16_t*)(F.lds + 34816); LAS bf16_t* VT = (LAS bf16_t*)(F.lds + 67584);
    LAS bf16_t* ATT = (LAS bf16_t*)(F.lds + 104448) + w * (16 * TT);
    LAS float* avec = (LAS float*)(F.lds + 122880); LAS float* Mvec = avec + 64; LAS float* wint = avec + 128; LAS float* eneg = avec + 192; LAS float* ssqp = avec + 256; LAS float* qnl = avec + 384;
    float nli = 0.f, nlf = 0.f, nmst = 0.f;
#define MLO_ISSUE_QK(it_) do { const int sh_ = (it_) >> 7, c_ = (it_) & 127, b_ = sh_ >> 2, h_ = sh_ & 3; const size_t t0_ = (size_t)b_ * SEQ + (size_t)c_ * 64; const bf16_t* pj_ = (const bf16_t*)(ws + WS_PROJ) + t0_ * NPROJ; \
        dma_rows<16>((LAS unsigned char*)QR, pj_ + C_MQ + h_ * 128 - 3 * (size_t)NPROJ, NPROJ, 17, w, lane); dma_rows<16>((LAS unsigned char*)KR, pj_ + C_MK + h_ * 128 - 3 * (size_t)NPROJ, NPROJ, 17, w, lane); \
        const float* gt_ = (const float*)(ws + WS_GATES) + (t0_ + lane) * 8; nli = gt_[h_]; nlf = gt_[4 + h_]; nmst = ((const float*)(ws + WS_MST))[(it_)]; \
        { const int cq_ = h_ * 128 + (tid & 127), ck_ = 512 + cq_; _Pragma("unroll") for (int j_ = 0; j_ < 4; ++j_) { ncw[j_] = p.in[5][1024 * j_ + cq_]; ncw[5 + j_] = p.in[5][1024 * j_ + ck_]; } ncw[4] = p.in[6][cq_]; ncw[9] = p.in[6][ck_]; } \
        nnw = p.in[9][h_ * 256 + (tid & 255)]; } while (0)
#define MLO_ISSUE_V(it_, col_) do { const int sh_ = (it_) >> 7, c_ = (it_) & 127, b_ = sh_ >> 2, h_ = sh_ & 3; const bf16_t* pj_ = (const bf16_t*)(ws + WS_PROJ) + ((size_t)b_ * SEQ + (size_t)c_ * 64) * NPROJ; \
        dma_rows<32>((LAS unsigned char*)VR, pj_ + (col_) + h_ * 256, NPROJ, 32, w, lane); } while (0)
    const int fr = lane & 15, fq = lane >> 4, tb = w & 3, vh = w >> 2;
    float ncw[10], nnw = 0.f;
    LAS float* nwl = avec + 512;
#pragma unroll
    for (int j = 0; j < 10; ++j) ncw[j] = 0.f;
    LBAR();
    int item = F.vcu;
    if (item < 1024) { MLO_ISSUE_QK(item); MLO_ISSUE_V(item, C_MV); }
    for (; item < 1024; item += F.G) {
        const int sh = item >> 7, c = item & 127, b = sh >> 2, h = sh & 3; const size_t t0 = (size_t)b * SEQ + (size_t)c * 64;
        const float li = nli, lf = nlf, mst = nmst;
        float cwv[10];
#pragma unroll
        for (int j = 0; j < 10; ++j) cwv[j] = ncw[j];
        const float nwx = nnw;
        VLBAR();
        if (tid < 256) nwl[tid] = nwx;
        f32x4 nsv[8]; bf16x8 ctf[4][4], ctg[4][4];
        { const bf16_t* CT = (const bf16_t*)(ws + WS_CST) + (size_t)item * 32768;
#pragma unroll
          for (int nb = 0; nb < 4; ++nb)
#pragma unroll
              for (int ks = 0; ks < 4; ++ks) ctf[nb][ks] = *(const bf16x8*)(CT + (size_t)(16 * (8 * vh + nb) + fr) * 128 + 32 * ks + 8 * fq); }
        __builtin_amdgcn_sched_barrier(0);
        if (w == 0) {
            float g = lf;
#pragma unroll
            for (int o = 1; o < 64; o <<= 1) { const float v = __shfl_up(g, o); if (lane >= o) g += v; }
            const float a = li - g; float pm = a;
#pragma unroll
            for (int o = 1; o < 64; o <<= 1) { const float v = __shfl_up(pm, o); if (lane >= o) pm = fmaxf(pm, v); }
            const float M = fmaxf(mst, pm);
            int ln = lane; asm volatile("" : "+v"(ln)); LAS float* gs = avec + ln;
            gs[0] = a; gs[64] = M; gs[128] = __expf(mst - M); gs[192] = __expf(-(g + M));
        }
        { const int v = tid & 255, hf = tid >> 8; unsigned pk[16];
#pragma unroll
          for (int j = 0; j < 16; ++j) pk[j] = (unsigned)VR[(32 * hf + 2 * j) * 256 + v] | ((unsigned)VR[(32 * hf + 2 * j + 1) * 256 + v] << 16);
#pragma unroll
          for (int q = 0; q < 4; ++q) *(LAS u32x4*)(VT + v * TT + 32 * hf + 8 * q) = (u32x4){pk[4 * q], pk[4 * q + 1], pk[4 * q + 2], pk[4 * q + 3]}; }
        const int d = tid & 127, tq = w >> 1;
        float rq[19], rk[19];
#pragma unroll
        for (int j = 0; j < 19; ++j) { const bool z = (c == 0 && 16 * tq + j < 3); const float a = bf2f(QR[(16 * tq + j) * 128 + d]), bb = bf2f(KR[(16 * tq + j) * 128 + d]); rq[j] = z ? 0.f : a; rk[j] = z ? 0.f : bb; }
        LBAR();
        MLO_ISSUE_V(item, C_MO);
        { const float q0 = cwv[0], q1 = cwv[1], q2 = cwv[2], q3 = cwv[3], qb = cwv[4], k0 = cwv[5], k1 = cwv[6], k2 = cwv[7], k3 = cwv[8], kb = cwv[9];
#pragma unroll
          for (int j = 0; j < 16; ++j) { const float a = qb + q0 * rq[j] + q1 * rq[j + 1] + q2 * rq[j + 2] + q3 * rq[j + 3]; const float bq = kb + k0 * rk[j] + k1 * rk[j + 1] + k2 * rk[j + 2] + k3 * rk[j + 3];
              const int t = 16 * tq + j, sw = t * 128 + ((((d >> 3) ^ (t & 15)) << 3) | (d & 7));
              QR[sw] = f2bf(a * sigmoidf_(a) * 0.08838834764831845f); KR[sw] = f2bf(bq * sigmoidf_(bq)); } }
        LBAR();
        { const float* nst = (const float*)(ws + WS_NST) + (size_t)item * 128;
#pragma unroll
          for (int ks = 0; ks < 4; ++ks) { nsv[2 * ks] = *(const f32x4*)(nst + 32 * ks + 8 * fq); nsv[2 * ks + 1] = *(const f32x4*)(nst + 32 * ks + 8 * fq + 4); } }
        __builtin_amdgcn_sched_barrier(0);
        bf16x8 aq[4];
#pragma unroll
        for (int ks = 0; ks < 4; ++ks) aq[ks] = *(const LAS bf16x8*)(QR + (16 * tb + fr) * 128 + (((4 * ks + fq) ^ fr) << 3));
        float Mr[4], wi[4], rsum[4];
#pragma unroll
        for (int i = 0; i < 4; ++i) { const int tl = 16 * tb + 4 * fq + i; Mr[i] = Mvec[tl]; wi[i] = wint[tl]; rsum[i] = 0.f; }
#pragma unroll
        for (int sb = 0; sb < 4; ++sb) {
            f32x4 acc = (f32x4){0.f, 0.f, 0.f, 0.f};
            if (sb <= tb) {
#pragma unroll
                for (int ks = 0; ks < 4; ++ks) acc = __builtin_amdgcn_mfma_f32_16x16x32_bf16(aq[ks], *(const LAS bf16x8*)(KR + (16 * sb + fr) * 128 + (((4 * ks + fq) ^ fr) << 3)), acc, 0, 0, 0);
            }
            const int s = 16 * sb + fr; const float as = avec[s];
#pragma unroll
            for (int i = 0; i < 4; ++i) { const int tl = 16 * tb + 4 * fq + i; const float v = (s <= tl) ? acc[i] * __expf(as - Mr[i]) : 0.f; rsum[i] += v; ATT[(4 * fq + i) * TT + s] = f2bf(v); }
        }
#pragma unroll
        for (int i = 0; i < 4; ++i) { float s = rsum[i]; s += __shfl_xor(s, 1); s += __shfl_xor(s, 2); s += __shfl_xor(s, 4); s += __shfl_xor(s, 8); rsum[i] = s; }
        f32x4 o[8];
#pragma unroll
        for (int nb = 0; nb < 4; ++nb) { o[nb] = (f32x4){0.f, 0.f, 0.f, 0.f};
#pragma unroll
            for (int ks = 0; ks < 4; ++ks) o[nb] = __builtin_amdgcn_mfma_f32_16x16x32_bf16(aq[ks], ctf[nb][ks], o[nb], 0, 0, 0);
#pragma unroll
            for (int i = 0; i < 4; ++i) o[nb][i] *= wi[i]; }
        { float s = 0.f;
#pragma unroll
          for (int ks = 0; ks < 4; ++ks) { const f32x4 n0 = nsv[2 * ks], n1 = nsv[2 * ks + 1];
              const unsigned* aw = (const unsigned*)&aq[ks];
              s += bflo(aw[0]) * n0[0] + bfhi(aw[0]) * n0[1] + bflo(aw[1]) * n0[2] + bfhi(aw[1]) * n0[3] + bflo(aw[2]) * n1[0] + bfhi(aw[2]) * n1[1] + bflo(aw[3]) * n1[2] + bfhi(aw[3]) * n1[3]; }
          s += __shfl_xor(s, 16); s += __shfl_xor(s, 32);
          if (fq == 0) qnl[w * 16 + fr] = s; }
        __builtin_amdgcn_sched_barrier(0);
        { const bf16_t* CT = (const bf16_t*)(ws + WS_CST) + (size_t)item * 32768;
#pragma unroll
          for (int nb = 0; nb < 4; ++nb)
#pragma unroll
              for (int ks = 0; ks < 4; ++ks) ctg[nb][ks] = *(const bf16x8*)(CT + (size_t)(16 * (8 * vh + 4 + nb) + fr) * 128 + 32 * ks + 8 * fq); }
        __builtin_amdgcn_sched_barrier(0);
        asm volatile("s_waitcnt lgkmcnt(0)" ::: "memory");
        bf16x8 aa[2];
#pragma unroll
        for (int ks = 0; ks < 2; ++ks) aa[ks] = lds_frag(ATT, fr, TT, 32 * ks + 8 * fq);
#pragma unroll
        for (int nb = 0; nb < 4; ++nb) { const int vrow = 16 * (8 * vh + nb) + fr;
#pragma unroll
            for (int ks = 0; ks < 2; ++ks) o[nb] = __builtin_amdgcn_mfma_f32_16x16x32_bf16(aa[ks], lds_frag(VT, vrow, TT, 32 * ks + 8 * fq), o[nb], 0, 0, 0); }
        __builtin_amdgcn_sched_barrier(0);
#pragma unroll
        for (int nb = 4; nb < 8; ++nb) { o[nb] = (f32x4){0.f, 0.f, 0.f, 0.f};
#pragma unroll
            for (int ks = 0; ks < 4; ++ks) o[nb] = __builtin_amdgcn_mfma_f32_16x16x32_bf16(aq[ks], ctg[nb - 4][ks], o[nb], 0, 0, 0);
#pragma unroll
            for (int i = 0; i < 4; ++i) o[nb][i] *= wi[i];
            const int vrow = 16 * (8 * vh + nb) + fr;
#pragma unroll
            for (int ks = 0; ks < 2; ++ks) o[nb] = __builtin_amdgcn_mfma_f32_16x16x32_bf16(aa[ks], lds_frag(VT, vrow, TT, 32 * ks + 8 * fq), o[nb], 0, 0, 0); }
        float sq[4];
#pragma unroll
        for (int i = 0; i < 4; ++i) { const int tl = 16 * tb + 4 * fq + i; const float den = wi[i] * qnl[w * 16 + 4 * fq + i] + rsum[i]; const float inv = 1.0f / fmaxf(fabsf(den), eneg[tl]);
            float s = 0.f;
#pragma unroll
            for (int nb = 0; nb < 8; ++nb) { o[nb][i] *= inv; s += o[nb][i] * o[nb][i]; }
            s += __shfl_xor(s, 1); s += __shfl_xor(s, 2); s += __shfl_xor(s, 4); s += __shfl_xor(s, 8); sq[i] = s; }
        if (fr == 0) {
#pragma unroll
            for (int i = 0; i < 4; ++i) ssqp[vh * 64 + 16 * tb + 4 * fq + i] = sq[i]; }
        VLBAR();
        if (item + F.G < 1024) MLO_ISSUE_QK(item + F.G);
#pragma unroll
        for (int i = 0; i < 4; ++i) { const int tl = 16 * tb + 4 * fq + i; const float r = 1.0f / sqrtf((ssqp[tl] + ssqp[64 + tl]) * (1.0f / 256.0f) + EPS);
#pragma unroll
            for (int nb = 0; nb < 8; ++nb) { const int v = 16 * (8 * vh + nb) + fr; const float g = bf2f(VR[tl * 256 + v]);
                VR[tl * 256 + v] = f2bf(o[nb][i] * r * nwl[v] * sigmoidf_(g)); } }
        LBAR();
        bf16_t* mix = (bf16_t*)(ws + WS_MIX) + t0 * DM + 1024 + h * 256;
        for (int cix = tid; cix < 2048; cix += 512) { const int r = cix >> 5, cc = cix & 31; *(u32x4*)(mix + (size_t)r * DM + cc * 8) = *(const LAS u32x4*)(VR + r * 256 + cc * 8); }
        LBAR();
        if (item + F.G < 1024) MLO_ISSUE_V(item + F.G, C_MV);
    }
#undef MLO_ISSUE_QK
#undef MLO_ISSUE_V
}

__device__ __forceinline__ void p4_router(const Params& p, Frame& F) {
    unsigned char* ws = p.ws;
    LAS float* part = (LAS float*)(F.lds);
    LAS float* ssqp = (LAS float*)(F.lds + 32768);
    LAS int* hist = (LAS int*)(F.lds + L_HIST); LAS int* gbase = hist + 32;
    const float* x1 = (const float*)(ws + WS_X1);
    unsigned* gcnt = (unsigned*)(ws + WS_CTL) + CW_CNT;
    for (int blk = F.vcu; blk < T_TOK / 64; blk += F.G) {
        const int g = F.wave >> 2, ks = F.wave & 3, r0 = blk * 64 + g * 32;
        f32x16 acc;
#pragma unroll
        for (int i = 0; i < 16; ++i) acc[i] = 0.f;
        float ssq;
        skinny_f32<1>(x1, r0, ks * 512, p.in[12], p.in[11], nullptr, acc, ssq, F.lane);
        const int n = F.lane & 31, hh = F.lane >> 5;
#pragma unroll
        for (int i = 0; i < 16; ++i) { const int row = (i & 3) + 8 * (i >> 2) + 4 * hh; part[((g * 4 + ks) * 32 + row) * 32 + n] = acc[i]; }
        if (F.lane < 32) ssqp[(g * 4 + ks) * 32 + F.lane] = ssq;
        if (F.tid < 32) hist[F.tid] = 0;
        __syncthreads();
        int es[4] = {0, 0, 0, 0}, lp[4] = {0, 0, 0, 0}; float gv[4] = {0.f, 0.f, 0.f, 0.f}; float rs = 0.f; const int t = blk * 64 + F.tid;
        if (F.tid < 64) {
            const int gg = F.tid >> 5, mm = F.tid & 31;
            float s = 0.f;
#pragma unroll
            for (int q = 0; q < 4; ++q) s += ssqp[(gg * 4 + q) * 32 + mm];
            rs = 1.0f / sqrtf(s * (1.0f / DM) + EPS);
            float lg[32];
#pragma unroll
            for (int e = 0; e < 32; ++e) { float v = 0.f;
#pragma unroll
                for (int q = 0; q < 4; ++q) v += part[((gg * 4 + q) * 32 + mm) * 32 + e];
                lg[e] = v * rs + p.in[13][e]; }
            unsigned used = 0u; float tv[4];
#pragma unroll
            for (int j = 0; j < 4; ++j) { float best = -3.0e38f; int bi = 0;
#pragma unroll
                for (int e = 0; e < 32; ++e) { const bool ok = !((used >> e) & 1u) && (lg[e] > best); best = ok ? lg[e] : best; bi = ok ? e : bi; }
                used |= 1u << bi; es[j] = bi; tv[j] = best; }
            float den = 0.f;
#pragma unroll
            for (int j = 0; j < 4; ++j) { gv[j] = __expf(tv[j] - tv[0]); den += gv[j]; }
            const float inv = 1.0f / den;
#pragma unroll
            for (int j = 0; j < 4; ++j) { gv[j] *= inv; lp[j] = __hip_atomic_fetch_add(&hist[es[j]], 1, __ATOMIC_RELAXED, __HIP_MEMORY_SCOPE_WORKGROUP); }
        }
        __syncthreads();
        if (F.tid < 32) { const int cnt = hist[F.tid]; gbase[F.tid] = cnt ? (int)atomicAdd(&gcnt[F.tid], (unsigned)cnt) : 0; }
        __syncthreads();
        if (F.tid < 64) {
            ((float*)(ws + WS_RSTD2))[t] = rs;
#pragma unroll
            for (int j = 0; j < 4; ++j) { const int e = es[j], pos = gbase[e] + lp[j];
                ((int*)(ws + WS_LTOK))[e * LIST_STRIDE + pos] = t; ((float*)(ws + WS_LRS))[e * LIST_STRIDE + pos] = rs;
                ((int*)(ws + WS_TOKE))[t * 4 + j] = e; ((int*)(ws + WS_TOKP))[t * 4 + j] = pos; ((float*)(ws + WS_TOKG))[t * 4 + j] = gv[j]; }
        }
        __syncthreads();
    }
}
__device__ __forceinline__ void moe_tables(const Params& p, Frame& F) {
    LAS int* tile0 = (LAS int*)(F.lds + L_TILE0); LAS int* cnt = (LAS int*)(F.lds + L_CNT);
    if (F.tid < 64) {
        const unsigned* gcnt = (const unsigned*)(p.ws + WS_CTL) + CW_CNT; const int e = F.tid & 31;
        const int c = (int)__hip_atomic_load(gcnt + e, __ATOMIC_RELAXED, __HIP_MEMORY_SCOPE_AGENT); const int nt = (c + 255) >> 8;
        int inc = nt;
#pragma unroll
        for (int o = 1; o < 32; o <<= 1) { const int v = __shfl_up(inc, o, 32); if (e >= o) inc += v; }
        if (F.tid < 32) { cnt[e] = c; tile0[e] = inc - nt; if (e == NEXP - 1) tile0[NEXP] = inc; }
    }
    __syncthreads();
}

__device__ __forceinline__ void p7_final(const Params& p, Frame& F) {
    unsigned char* ws = p.ws; const LAS int* tile0 = (const LAS int*)(F.lds + L_TILE0);
    const float* x1 = (const float*)(ws + WS_X1); const unsigned char* ys = (const unsigned char*)(ws + WS_YS); const float* fw = p.in[20];
    const int gw = F.vcu * 8 + F.wave, NGW = F.G * 8, lane = F.lane;
    LAS float* fwl = (LAS float*)(F.lds + 16384);
    for (int i = F.tid; i < DM; i += 512) fwl[i] = fw[i];
    __syncthreads();
    if (gw >= T_TOK) return;
    f32x4 v[8], nv[8]; i32x4 me, mp, nme, nmp; f32x4 mg, nmg;
#define P7_LOAD(V_, E_, P_, G_, t_) do { E_ = *(const i32x4*)((const int*)(ws + WS_TOKE) + (t_) * 4); P_ = *(const i32x4*)((const int*)(ws + WS_TOKP) + (t_) * 4); G_ = *(const f32x4*)((const float*)(ws + WS_TOKG) + (t_) * 4); \
        _Pragma("unroll") for (int i_ = 0; i_ < 4; ++i_) { V_[2 * i_] = *(const f32x4*)(x1 + (size_t)(t_) * DM + 512 * i_ + 8 * lane); V_[2 * i_ + 1] = *(const f32x4*)(x1 + (size_t)(t_) * DM + 512 * i_ + 8 * lane + 4); } } while (0)
    P7_LOAD(v, me, mp, mg, gw);
    for (int t = gw; t < T_TOK; t += NGW) {
        u32x2 y[4][4];
#pragma unroll
        for (int j = 0; j < 4; ++j) { const size_t slot = (size_t)tile0[me[j]] * 256 + mp[j];
#pragma unroll
            for (int i = 0; i < 4; ++i) y[j][i] = *(const u32x2*)(ys + slot * DM + 512 * i + 8 * lane); }
        const int tn = (t + NGW < T_TOK) ? t + NGW : t;
        P7_LOAD(nv, nme, nmp, nmg, tn);
#pragma unroll
        for (int j = 0; j < 4; ++j) { const float g = mg[j]; __builtin_amdgcn_sched_barrier(0);
#pragma unroll
            for (int i = 0; i < 4; ++i) {
                const f32x2_t a0 = __builtin_amdgcn_cvt_pk_f32_fp8(y[j][i].x, false), a1 = __builtin_amdgcn_cvt_pk_f32_fp8(y[j][i].x, true), a2 = __builtin_amdgcn_cvt_pk_f32_fp8(y[j][i].y, false), a3 = __builtin_amdgcn_cvt_pk_f32_fp8(y[j][i].y, true);
                v[2 * i][0] += g * a0.x; v[2 * i][1] += g * a0.y; v[2 * i][2] += g * a1.x; v[2 * i][3] += g * a1.y;
                v[2 * i + 1][0] += g * a2.x; v[2 * i + 1][1] += g * a2.y; v[2 * i + 1][2] += g * a3.x; v[2 * i + 1][3] += g * a3.y; } }
        float s = 0.f;
#pragma unroll
        for (int i = 0; i < 8; ++i) s += (v[i][0] * v[i][0] + v[i][1] * v[i][1]) + (v[i][2] * v[i][2] + v[i][3] * v[i][3]);
        const float rs = 1.0f / sqrtf(wave_sum(s) * (1.0f / DM) + EPS);
        int fo = 8 * lane; asm volatile("" : "+v"(fo));
#pragma unroll
        for (int i = 0; i < 4; ++i) {
            const f32x4 w0 = *(const LAS f32x4*)(fwl + 512 * i + fo), w1 = *(const LAS f32x4*)(fwl + 512 * i + fo + 4);
            *(f32x4*)(p.out + (size_t)t * DM + 512 * i + 8 * lane) = v[2 * i] * rs * w0; *(f32x4*)(p.out + (size_t)t * DM + 512 * i + 8 * lane + 4) = v[2 * i + 1] * rs * w1; }
#pragma unroll
        for (int i = 0; i < 8; ++i) v[i] = nv[i];
        me = nme; mp = nmp; mg = nmg;
    }
#undef P7_LOAD
}

#ifndef NG_GEMM
#define NG_GEMM 180
#endif
#ifndef NG_MOE1
#define NG_MOE1 232
#endif
constexpr int CONV_N_GU = NEXP * 2 * (DM / 128) * (DFF / 64), CONV_N_ALL = NEXP * 3 * (DM / 128) * (DFF / 64);
constexpr int N_PHASES = 10;
__global__ void __launch_bounds__(512, 2) hymba_fwd(Params p) {
    extern __shared__ __attribute__((aligned(16))) unsigned char lds_raw[];
    Frame F; F.lds = (LAS unsigned char*)lds_raw; F.tid = threadIdx.x; F.lane = F.tid & 63; F.wave = __builtin_amdgcn_readfirstlane(F.tid >> 6);
    F.G = gridDim.x; { const int bx = blockIdx.x; F.vcu = (F.G % 8 == 0) ? (bx % 8) * (F.G / 8) + bx / 8 : bx; }
    for (int u = F.tid; u < (LDS_BYTES - LDSCTL_OFF) / 4; u += 512) ((LAS unsigned*)(F.lds + LDSCTL_OFF))[u] = 0u;
    __syncthreads();
    unsigned char* ws = p.ws;
    unsigned* ctl = (unsigned*)(ws + WS_CTL);
    XcdBarrier bar; bar.bar = ctl + CW_BAR + p.li * XCD_BAR_WORDS; bar.x = 0; bar.st = nullptr;
    const int lo = p.ph_lo, hi = p.ph_hi;
    if (hi - lo > 1) bar = xcd_barrier_post(ctl + CW_BAR + p.li * XCD_BAR_WORDS, (volatile LAS unsigned*)(F.lds + L_MISC) + 8);
#define IN(k) (lo <= (k) && (k) < hi)
#define SEAM(k) do { if (IN(k) && IN((k) + 1)) xcd_barrier(bar); } while (0)
    LAS unsigned char* ring = F.lds;

    if (IN(0)) { p0_prologue(p, F); }
    SEAM(0);
    if (IN(1)) {
        const int ng = (F.G == 256) ? NG_GEMM : F.G;
        if ((int)blockIdx.x < ng) {
            pg8::Gemm g{(const bf16_t*)(ws + WS_XB), (const bf16_t*)(ws + WS_WIN), DM}; pg8::StaticOrder S; S.init(T_TOK, NPROJ, ng, (int)blockIdx.x);
            EpiProj E{(bf16_t*)(ws + WS_PROJ), (const float*)(ws + WS_RSTD1)};
            pg8::gemm_phase<EpiProj, pg8::StaticOrder, false, false, true, false>(ring, g, S, E);
            if (ng == F.G) { wout_transpose(p, F, (int)blockIdx.x * 8 + F.wave, F.G * 8); moe_weight_convert(p, F, (int)blockIdx.x * 8 + F.wave, F.G * 8, 0, CONV_N_GU); }
        } else { wout_transpose(p, F, ((int)blockIdx.x - ng) * 8 + F.wave, (F.G - ng) * 8); moe_weight_convert(p, F, ((int)blockIdx.x - ng) * 8 + F.wave, (F.G - ng) * 8, 0, CONV_N_GU); }
    }
    SEAM(1);
    if (IN(2)) {
        hg_local_phase(p, F); ml_local_phase(p, F);
    }
    SEAM(2);
    if (IN(3)) { p2_scan(p, F); }
    SEAM(3);
    if (IN(4)) {
        hg_out_phase(p, F); ml_out_phase(p, F);
    }
    SEAM(4);
    if (IN(5)) {
        pg8::Gemm g{(const bf16_t*)(ws + WS_MIX), (const bf16_t*)(ws + WS_WOUT), DM}; pg8::StaticOrder S; S.init(T_TOK, DM, F.G, (int)blockIdx.x);
        EpiOut E{p.in[0], (float*)(ws + WS_X1), (unsigned char*)(ws + WS_X1B), F.lds + 131072};
        pg8::gemm_phase<EpiOut, pg8::StaticOrder, false, false, true, false>(ring, g, S, E);
    }
    SEAM(5);
    if (IN(6)) { p4_router(p, F); }
    SEAM(6);
    if (IN(7)) {
        const int ngm = (F.G == 256) ? NG_MOE1 : F.G;
        if (ngm == F.G) { moe_weight_convert(p, F, (int)blockIdx.x * 8 + F.wave, F.G * 8, CONV_N_GU, CONV_N_ALL); __syncthreads(); }
        if ((int)blockIdx.x < ngm) {
        moe_tables(p, F);
        pg8::Gemm g{(const bf16_t*)(ws + WS_X1B), (const bf16_t*)(ws + WS_WGU), DM / 2};
        pg8::MoeOrder S; S.init((const LAS int*)(F.lds + L_TILE0), (const LAS int*)(F.lds + L_CNT), (const int*)(ws + WS_LTOK), 16, ngm, (int)blockIdx.x);
        EpiMoe1 E{(unsigned char*)(ws + WS_ACT), p.in[15], p.in[17], (const float*)(ws + WS_LRS), (const LAS int*)(F.lds + L_CNT)};
        pg8::gemm_phase<EpiMoe1, pg8::MoeOrder, true, true, false, true>(ring, g, S, E);
        } else moe_weight_convert(p, F, ((int)blockIdx.x - ngm) * 8 + F.wave, (F.G - ngm) * 8, CONV_N_GU, CONV_N_ALL);
    }
    SEAM(7);
    if (IN(8)) {
        moe_tables(p, F);
        pg8::Gemm g{(const bf16_t*)(ws + WS_ACT), (const bf16_t*)(ws + WS_WDN), DFF / 2};
        pg8::MoeOrder S; S.init((const LAS int*)(F.lds + L_TILE0), (const LAS int*)(F.lds + L_CNT), (const int*)(ws + WS_LTOK), 8, F.G, (int)blockIdx.x);
        EpiMoe2 E{(unsigned char*)(ws + WS_YS), p.in[19]};
        pg8::gemm_phase<EpiMoe2, pg8::MoeOrder, false, true, false, true>(ring, g, S, E);
    }
    SEAM(8);
    if (IN(9)) { moe_tables(p, F); p7_final(p, F); }
#undef IN
#undef SEAM
}

extern "C" void kernel_launch(void* const* d_in, const int* in_sizes, int n_in, void* d_out, int out_size, void* d_ws, size_t ws_size, hipStream_t stream) {
    static int grid = 0;
    if (grid == 0) {
        if (n_in != 21 || in_sizes[0] != T_TOK * DM || out_size != T_TOK * DM || ws_size < WS_END) { fprintf(stderr, "kernel_launch: unexpected shapes / workspace (n_in %d, ws %zu < %zu)\n", n_in, ws_size, (size_t)WS_END); grid = -1; return; }
        int dev = 0, cus = 0, per_cu = 0;
        if (hipGetDevice(&dev) != hipSuccess || hipDeviceGetAttribute(&cus, hipDeviceAttributeMultiprocessorCount, dev) != hipSuccess) { grid = -1; return; }
        if (hipFuncSetAttribute((const void*)hymba_fwd, hipFuncAttributeMaxDynamicSharedMemorySize, LDS_BYTES) != hipSuccess) { fprintf(stderr, "kernel_launch: hipFuncSetAttribute failed\n"); grid = -1; return; }
        if (hipOccupancyMaxActiveBlocksPerMultiprocessor(&per_cu, (const void*)hymba_fwd, 512, LDS_BYTES) != hipSuccess || per_cu < 1) { fprintf(stderr, "kernel_launch: occupancy query says %d\n", per_cu); }
        (void)hipGetLastError();
        grid = cus;
    }
    if (grid < 0) return;
    (void)hipMemsetAsync((char*)d_ws + WS_CTL, 0, CTL_ZERO_BYTES, stream);
    Params p{};
    for (int i = 0; i < 21; ++i) p.in[i] = (const float*)d_in[i];
    p.out = (float*)d_out; p.ws = (unsigned char*)d_ws; p.pad = 0;
#if MK_N_LAUNCHES == 1
    p.ph_lo = 0; p.ph_hi = N_PHASES; p.li = 0;
    hipLaunchKernelGGL(hymba_fwd, dim3(grid), dim3(512), LDS_BYTES, stream, p);
#else
    for (int k = 0; k < N_PHASES; ++k) { p.ph_lo = k; p.ph_hi = k + 1; p.li = 0; hipLaunchKernelGGL(hymba_fwd, dim3(grid), dim3(512), LDS_BYTES, stream, p); }
#endif
}
```
